# Optimizing an MI355X kernel written in HIP

```python
import math
import jax
import jax.numpy as jnp
from jax import lax
import numpy as np

D_MODEL = 2048
BATCH = 32
SEQ = 256
DEPTH = 4
DEC_BATCH = 2
DEC_SEQ = 2048
PAST_LEN = 256

GRID_W = 64
N_EVEN = (DEPTH + 1) // 2
N_ODD = DEPTH // 2
H_A = 6
DH_A = 128
W_A = H_A * 2 * DH_A
G_B = 4
DG_B = 128
W_B = G_B * DG_B
H_C = 16
Q_LORA = 1536
KV_LORA = 512
NOPE_C = 128
ROPE_C = 64
DQK_C = NOPE_C + ROPE_C
DV_C = 128
D_FF = 5632
N_MOD = 9
ROPE_BASE = 10000.0
Q_BLOCK = 128
EPS = 1e-6

kernel_name = 'hybrid_diffusion_prefix_step'


def rms_norm(x, g):
    xf = x.astype(jnp.float32)
    y = xf * lax.rsqrt(jnp.mean(xf * xf, axis=-1, keepdims=True) + EPS)
    return (y * g.astype(jnp.float32)).astype(x.dtype)


def swiglu(h, w_gate, w_up, w_down):
    return (jax.nn.silu(h @ w_gate) * (h @ w_up)) @ w_down


def axial_rope_tables(rows, rot_dim):
    row = jnp.repeat(jnp.arange(rows, dtype=jnp.float32), GRID_W)
    col = jnp.tile(jnp.arange(GRID_W, dtype=jnp.float32), rows)
    half = rot_dim // 2
    inv_freq = ROPE_BASE ** (-jnp.arange(0, half, 2, dtype=jnp.float32) / half)
    ang_r = row[:, None] * inv_freq[None, :]
    ang_c = col[:, None] * inv_freq[None, :]
    ang_r = jnp.concatenate([ang_r, ang_r], axis=-1)
    ang_c = jnp.concatenate([ang_c, ang_c], axis=-1)
    return (jnp.cos(ang_r), jnp.sin(ang_r), jnp.cos(ang_c), jnp.sin(ang_c))


def rotate(x, cos, sin):
    x1, x2 = jnp.split(x, 2, axis=-1)
    return x * cos + jnp.concatenate([-x2, x1], axis=-1) * sin


def apply_axial_rope(x, tables, n_mid):
    cos_r, sin_r, cos_c, sin_c = [t.reshape(t.shape[0], *([1] * n_mid), t.shape[1]) for t in tables]
    xf = x.astype(jnp.float32)
    xr, xc = jnp.split(xf, 2, axis=-1)
    out = jnp.concatenate([rotate(xr, cos_r, sin_r), rotate(xc, cos_c, sin_c)], axis=-1)
    return out.astype(x.dtype)


def sweep_query_blocks(block_fn, q):
    b, h, sq = q.shape[:3]
    nb = sq // Q_BLOCK
    qb = jnp.moveaxis(q.reshape(b, h, nb, Q_BLOCK, *q.shape[3:]), 2, 0)
    out = lax.map(block_fn, qb)
    return jnp.moveaxis(out, 0, 2).reshape(b, h, sq, out.shape[-1])


def softmax_f32(s):
    return jax.nn.softmax(s.astype(jnp.float32), axis=-1)


def diff_fourier_mixer(h, w_in, w_out, g_q, g_k, lam_vecs, g_sub, lam_init, ctx_k, ctx_v, rope):
    b, s, _ = h.shape
    q, k, v, f = jnp.split(h @ w_in, [W_A, 2 * W_A, 3 * W_A], axis=-1)
    q = rms_norm(q.reshape(b, s, H_A, 2, DH_A), g_q)
    k = rms_norm(k.reshape(b, s, H_A, 2, DH_A), g_k)
    v = v.reshape(b, s, H_A, 2 * DH_A)
    if rope is not None:
        q = apply_axial_rope(q, rope, 2)
        k = apply_axial_rope(k, rope, 2)
    q = q.transpose(0, 2, 1, 3, 4)
    k = k.transpose(0, 2, 1, 3, 4)
    v = v.transpose(0, 2, 1, 3)
    new_k = k.reshape(b, H_A, s, 2 * DH_A)
    new_v = v
    if ctx_k is not None:
        k = jnp.concatenate([k, ctx_k.reshape(b, H_A, ctx_k.shape[2], 2, DH_A)], axis=2)
        v = jnp.concatenate([v, ctx_v], axis=2)
    lam = (jnp.exp(jnp.sum(lam_vecs[0].astype(jnp.float32) * lam_vecs[1].astype(jnp.float32)))
           - jnp.exp(jnp.sum(lam_vecs[2].astype(jnp.float32) * lam_vecs[3].astype(jnp.float32))) + lam_init)
    scale = DH_A ** -0.5

    def block(qb):
        p = softmax_f32(jnp.einsum('bhqcd,bhkcd->cbhqk', qb, k) * scale)
        attn = (p[0] - lam * p[1]).astype(v.dtype)
        return jnp.einsum('bhqk,bhkv->bhqv', attn, v)

    o = sweep_query_blocks(block, q)
    o = rms_norm(o, g_sub) * (1.0 - lam_init)
    o = o.transpose(0, 2, 1, 3).reshape(b, s, W_A)
    fg = f.reshape(b, s, G_B, DG_B).astype(jnp.float32)
    fo = jnp.real(jnp.fft.fft2(fg, axes=(1, 3), norm='ortho')).astype(h.dtype).reshape(b, s, W_B)
    y = jnp.concatenate([o, fo], axis=-1) @ w_out
    return y, new_k, new_v


def mla_mixer(h, w_in, g_q_lora, w_uq, g_kv_lora, w_ukv, g_q, g_k, w_o, ctx_ckv, ctx_kpe, rope):
    b, s, _ = h.shape
    c_q, c_kv, k_pe = jnp.split(h @ w_in, [Q_LORA, Q_LORA + KV_LORA], axis=-1)
    c_kv = rms_norm(c_kv, g_kv_lora)
    q = rms_norm((rms_norm(c_q, g_q_lora) @ w_uq).reshape(b, s, H_C, DQK_C), g_q)

    def expand(ckv, kpe):
        n = ckv.shape[1]
        kv = (ckv @ w_ukv).reshape(b, n, H_C, NOPE_C + DV_C)
        k_nope, val = jnp.split(kv, [NOPE_C], axis=-1)
        kpe_h = jnp.broadcast_to(kpe[:, :, None, :], (b, n, H_C, ROPE_C))
        return rms_norm(jnp.concatenate([k_nope, kpe_h], axis=-1), g_k), val

    k, v = expand(c_kv, k_pe)
    if rope is not None:
        q = jnp.concatenate([q[..., :NOPE_C], apply_axial_rope(q[..., NOPE_C:], rope, 1)], axis=-1)
        k = jnp.concatenate([k[..., :NOPE_C], apply_axial_rope(k[..., NOPE_C:], rope, 1)], axis=-1)
    if ctx_ckv is not None:
        k_c, v_c = expand(ctx_ckv, ctx_kpe)
        k = jnp.concatenate([k, k_c], axis=1)
        v = jnp.concatenate([v, v_c], axis=1)
    q = q.transpose(0, 2, 1, 3)
    k = k.transpose(0, 2, 1, 3)
    v = v.transpose(0, 2, 1, 3)
    scale = DQK_C ** -0.5

    def block(qb):
        p = softmax_f32(jnp.einsum('bhqd,bhkd->bhqk', qb, k) * scale).astype(v.dtype)
        return jnp.einsum('bhqk,bhkv->bhqv', p, v)

    o = sweep_query_blocks(block, q).transpose(0, 2, 1, 3).reshape(b, s, H_C * DV_C)
    return o @ w_o, c_kv, k_pe


def setup_inputs(seed: int = 0) -> dict:
    key = jax.random.key(seed)
    ks = iter(jax.random.split(key, 40))

    def nrm(shape, scale):
        return jax.random.normal(next(ks), shape, jnp.float32) * scale

    def gain(shape):
        return 1.0 + 0.05 * jax.random.normal(next(ks), shape, jnp.float32)

    return {
        'x_prompt': nrm((BATCH, SEQ, D_MODEL), 1.0),
        'x_sample': nrm((DEC_BATCH, DEC_SEQ, D_MODEL), 1.0),
        'c': nrm((DEC_BATCH, D_MODEL), 1.0),
        'cache_diff_k': nrm((DEC_BATCH, N_EVEN, H_A, PAST_LEN, 2 * DH_A), 1.0),
        'cache_diff_v': nrm((DEC_BATCH, N_EVEN, H_A, PAST_LEN, 2 * DH_A), 1.0),
        'cache_mla_ckv': nrm((DEC_BATCH, N_ODD, PAST_LEN, KV_LORA), 1.0),
        'cache_mla_kpe': nrm((DEC_BATCH, N_ODD, PAST_LEN, ROPE_C), 1.0),
        'c_ctx': nrm((D_MODEL,), 1.0),
        'w_mod': nrm((DEPTH, D_MODEL, N_MOD * D_MODEL), 0.5 * D_MODEL ** -0.5),
        'b_mod': nrm((DEPTH, N_MOD * D_MODEL), 0.01),
        'g_norm': gain((DEPTH, 3, D_MODEL)),
        'w_ffn_gate': nrm((DEPTH, 2, D_MODEL, D_FF), D_MODEL ** -0.5),
        'w_ffn_up': nrm((DEPTH, 2, D_MODEL, D_FF), D_MODEL ** -0.5),
        'w_ffn_down': nrm((DEPTH, 2, D_FF, D_MODEL), D_FF ** -0.5),
        'w_in_ab': nrm((N_EVEN, D_MODEL, 3 * W_A + W_B), D_MODEL ** -0.5),
        'w_out_ab': nrm((N_EVEN, W_A + W_B, D_MODEL), (W_A + W_B) ** -0.5),
        'g_qk_diff': gain((N_EVEN, 2, DH_A)),
        'diff_lambda': nrm((N_EVEN, 4, DH_A), 0.1),
        'g_diff_sub': gain((N_EVEN, 2 * DH_A)),
        'w_in_mla': nrm((N_ODD, D_MODEL, Q_LORA + KV_LORA + ROPE_C), D_MODEL ** -0.5),
        'g_q_lora': gain((N_ODD, Q_LORA)),
        'w_uq': nrm((N_ODD, Q_LORA, H_C * DQK_C), Q_LORA ** -0.5),
        'g_kv_lora': gain((N_ODD, KV_LORA)),
        'w_ukv': nrm((N_ODD, KV_LORA, H_C * (NOPE_C + DV_C)), KV_LORA ** -0.5),
        'g_qk_mla': gain((N_ODD, 2, DQK_C)),
        'w_o_mla': nrm((N_ODD, H_C * DV_C, D_MODEL), (H_C * DV_C) ** -0.5),
    }


def reference(x_prompt, x_sample, c, cache_diff_k, cache_diff_v, cache_mla_ckv, cache_mla_kpe, c_ctx,
              w_mod, b_mod, g_norm, w_ffn_gate, w_ffn_up, w_ffn_down,
              w_in_ab, w_out_ab, g_qk_diff, diff_lambda, g_diff_sub,
              w_in_mla, g_q_lora, w_uq, g_kv_lora, w_ukv, g_qk_mla, w_o_mla):
    ROWS = x_sample.shape[1] // GRID_W
    rope_a = axial_rope_tables(ROWS, DH_A)
    rope_c = axial_rope_tables(ROWS, ROPE_C)

    def layer(l, x, cond, ctx0, ctx1, rp_a, rp_c):
        mod = (jax.nn.silu(cond) @ w_mod[l] + b_mod[l])[:, None, :]
        sh1, sc1, gt1, sh2, sc2, gt2, sh3, sc3, gt3 = jnp.split(mod, N_MOD, axis=-1)
        h = rms_norm(x, g_norm[l, 0]) * (1.0 + sc1) + sh1
        x = x + 0.5 * gt1 * swiglu(h, w_ffn_gate[l, 0], w_ffn_up[l, 0], w_ffn_down[l, 0])
        h = rms_norm(x, g_norm[l, 1]) * (1.0 + sc2) + sh2
        if l % 2 == 0:
            e = l // 2
            lam_init = 0.8 - 0.6 * math.exp(-0.3 * l)
            y, st0, st1 = diff_fourier_mixer(h, w_in_ab[e], w_out_ab[e], g_qk_diff[e, 0], g_qk_diff[e, 1],
                                             diff_lambda[e], g_diff_sub[e], lam_init, ctx0, ctx1, rp_a)
        else:
            o = l // 2
            y, st0, st1 = mla_mixer(h, w_in_mla[o], g_q_lora[o], w_uq[o], g_kv_lora[o], w_ukv[o],
                                    g_qk_mla[o, 0], g_qk_mla[o, 1], w_o_mla[o], ctx0, ctx1, rp_c)
        x = x + gt2 * y
        h = rms_norm(x, g_norm[l, 2]) * (1.0 + sc3) + sh3
        x = x + 0.5 * gt3 * swiglu(h, w_ffn_gate[l, 1], w_ffn_up[l, 1], w_ffn_down[l, 1])
        return x, st0, st1

    y_prompt = x_prompt
    cond_ctx = c_ctx[None, :]
    diff_k, diff_v, mla_ckv, mla_kpe = [], [], [], []
    for l in range(DEPTH):
        y_prompt, st0, st1 = layer(l, y_prompt, cond_ctx, None, None, None, None)
        if l % 2 == 0:
            diff_k.append(st0)
            diff_v.append(st1)
        else:
            mla_ckv.append(st0)
            mla_kpe.append(st1)

    y_sample = x_sample
    for l in range(DEPTH):
        j = l // 2
        if l % 2 == 0:
            ctx0, ctx1 = cache_diff_k[:, j], cache_diff_v[:, j]
        else:
            ctx0, ctx1 = cache_mla_ckv[:, j], cache_mla_kpe[:, j]
        y_sample, _, _ = layer(l, y_sample, c, ctx0, ctx1, rope_a, rope_c)

    new_diff_k = jnp.stack(diff_k, axis=1)
    new_diff_v = jnp.stack(diff_v, axis=1)
    new_mla_ckv = jnp.stack(mla_ckv, axis=1)
    new_mla_kpe = jnp.stack(mla_kpe, axis=1)
    return (y_prompt, y_sample, new_diff_k, new_diff_v, new_mla_ckv, new_mla_kpe)
```

```cpp
#include <hip/hip_runtime.h>
#include <hip/hip_bf16.h>
#include <cstdio>
#include <cstdint>

namespace pg8 {
#define PG8_LAS __attribute__((address_space(3)))
typedef unsigned short bf16_t;
typedef short bf16x8 __attribute__((ext_vector_type(8)));
typedef float f32x4 __attribute__((ext_vector_type(4)));
typedef float f32x2 __attribute__((ext_vector_type(2)));
typedef unsigned u32x4 __attribute__((ext_vector_type(4)));
typedef unsigned u32x2 __attribute__((ext_vector_type(2)));
constexpr int BM = 256, BK = 64, HALF = 128, HTB = HALF * BK * 2  , STAGE_BYTES = 8 * HTB, NXCD = 8, WGM = 8;

__host__ __device__ __forceinline__ int lds_byte(int r, int c) { const int st = (r >> 4) * 2 + (c >> 5), rr = r & 15, cc = c & 31, ob = rr * 64 + cc * 2; return st * 1024 + (ob ^ (((ob >> 9) & 1) << 5)); }
__host__ __device__ __forceinline__ void stage_rc(int b, int& R, int& C) { const int st = b / 1024, sb = b % 1024, swz = sb ^ (((sb >> 9) & 1) << 5); R = (st >> 1) * 16 + swz / 64; C = (st & 1) * 32 + (swz % 64) / 2; }
__host__ __device__ __forceinline__ int perm32(int rho) { const int n = rho >> 4, i = rho & 15; return 8 * (i >> 2) + 4 * n + (i & 3); }

struct Unit { int pm, pn; long z; const char* A; const char* B; };
struct Dims { int lda, ldb, nt; };

struct TileOrder {
    int nM, nN, nwg, G, c;
    __device__ void init(int nM_, int nN_, int G_, int c_) { nM = nM_; nN = nN_; nwg = nM * nN; G = G_; c = c_; }
    __device__ bool tile(int i, int& pm, int& pn) const {
        const long L = (long)i * G + c; if (L >= nwg) return false;
        int wgid = (int)L; { const int q = nwg / NXCD, r = nwg % NXCD, xcd = wgid % NXCD, off = wgid / NXCD; wgid = (xcd < r ? xcd * (q + 1) : r * (q + 1) + (xcd - r) * q) + off; }
        const int nig = WGM * nN, gid = wgid / nig, fm = gid * WGM, gsz = (nM - fm) < WGM ? (nM - fm) : WGM;
        pm = fm + ((wgid % nig) % gsz); pn = (wgid % nig) / gsz; return true;
    }
};
struct PlainOrder {
    TileOrder T; const char* A; const char* Bt; size_t ta, tb;
    __device__ void init(const void* A_, const void* Bt_, int M, int N, int lda, int ldb, int G, int c) { T.init(M / BM, N / BM, G, c); A = (const char*)A_; Bt = (const char*)Bt_; ta = (size_t)BM * lda * 2; tb = (size_t)BM * ldb * 2; }
    __device__ bool next(int i, Unit& u) const { int pm, pn; if (!T.tile(i, pm, pn)) return false; u.pm = pm; u.pn = pn; u.z = 0; u.A = A + (size_t)pm * ta; u.B = Bt + (size_t)pn * tb; return true; }
};

__device__ __forceinline__ unsigned cvt_pk_bf16(float lo, float hi) { unsigned r; asm volatile("v_cvt_pk_bf16_f32 %0, %1, %2" : "=v"(r) : "v"(lo), "v"(hi)); return r; }

template <class Epi, class Sched>
__device__ __forceinline__ void gemm_phase(PG8_LAS unsigned char* lds, const Dims g, const Sched& S, const Epi& E) {
    int tid_ = threadIdx.x; asm volatile("" : "+v"(tid_));
    const int tid = tid_, wid = __builtin_amdgcn_readfirstlane(tid >> 6), lane = tid & 63, wr = wid >> 2, wc = wid & 3, fr = lane & 15, fq = lane >> 4;
    const int nt = g.nt;
    unsigned voffA[2], voffB[2];
#pragma unroll
    for (int i = 0; i < 2; ++i) { int R, C; stage_rc(tid * 16 + i * 8192, R, C); const int Rb = Epi::PERM ? ((R & ~31) + perm32(R & 31)) : R;
        voffA[i] = (unsigned)(R * g.lda + C) * 2u; voffB[i] = (unsigned)(Rb * g.ldb + C) * 2u; }
    const size_t kstep = (size_t)(BK * 2);
    const size_t hsA = (size_t)HALF * g.lda * 2, hsB = (size_t)HALF * g.ldb * 2;
    const unsigned ldsw = (unsigned)wid * 1024u;
    const int aoff = lds_byte(wr * 64 + fr, fq * 8), boff = lds_byte(wc * 32 + fr, fq * 8);
#define PG8_SA(b, h) (((b) * 2 + (h)) * HTB)
#define PG8_SB(b, h) ((4 + (b) * 2 + (h)) * HTB)
#define PG8_STAGE(bufoff, gbase, voff) do { _Pragma("unroll") for (int _i = 0; _i < 2; ++_i) \
        __builtin_amdgcn_global_load_lds((const unsigned*)((const char*)(gbase) + (voff)[_i]), (PG8_LAS unsigned*)(lds + (bufoff) + ldsw + _i * 8192), 16, 0, 0); } while (0)
#define PG8_LDA(dst, b, h) do { _Pragma("unroll") for (int m = 0; m < 4; ++m) _Pragma("unroll") for (int k = 0; k < 2; ++k) dst[m][k] = *(const PG8_LAS bf16x8*)(lds + PG8_SA(b, h) + aoff + m * 2048 + k * 1024); } while (0)
#define PG8_LDB(dst, b, h) do { _Pragma("unroll") for (int n = 0; n < 2; ++n) _Pragma("unroll") for (int k = 0; k < 2; ++k) dst[n][k] = *(const PG8_LAS bf16x8*)(lds + PG8_SB(b, h) + boff + n * 2048 + k * 1024); } while (0)
#define PG8_MMA(ai, bj, At, Bt) do { __builtin_amdgcn_s_setprio(1); _Pragma("unroll") for (int m = 0; m < 4; ++m) _Pragma("unroll") for (int n = 0; n < 2; ++n) _Pragma("unroll") for (int k = 0; k < 2; ++k) \
        acc[ai][bj][m][n] = __builtin_amdgcn_mfma_f32_16x16x32_bf16(Bt[n][k], At[m][k], acc[ai][bj][m][n], 0, 0, 0); __builtin_amdgcn_s_setprio(0); } while (0)
#define PG8_WAIT_V(n) asm volatile("s_waitcnt vmcnt(" #n ")" ::: "memory")
#define PG8_WAIT_L(n) asm volatile("s_waitcnt lgkmcnt(" #n ")" ::: "memory")
#define PG8_BAR __builtin_amdgcn_s_barrier()
#define PG8_SCHED __builtin_amdgcn_sched_barrier(0)
    Unit cur, nxt; int ui = 0;
    if (!S.next(0, cur)) return;
    f32x4 acc[2][2][4][2];
#pragma unroll
    for (int a = 0; a < 2; ++a)
#pragma unroll
        for (int b = 0; b < 2; ++b)
#pragma unroll
            for (int m = 0; m < 4; ++m)
#pragma unroll
                for (int n = 0; n < 2; ++n) acc[a][b][m][n] = (f32x4){0.f, 0.f, 0.f, 0.f};
    bf16x8 At[4][2], B0[2][2], B1[2][2];
    const char* cA = cur.A; const char* cB = cur.B;
    PG8_STAGE(PG8_SB(0, 0), cB, voffB); PG8_STAGE(PG8_SB(0, 1), cB + hsB, voffB); PG8_STAGE(PG8_SA(0, 0), cA, voffA); PG8_STAGE(PG8_SA(0, 1), cA + hsA, voffA);
    if (wr == 1) PG8_BAR;
    PG8_WAIT_V(2); PG8_BAR;
    PG8_STAGE(PG8_SB(1, 0), cB + kstep, voffB); PG8_STAGE(PG8_SA(1, 0), cA + kstep, voffA); PG8_STAGE(PG8_SB(1, 1), cB + hsB + kstep, voffB);
    PG8_WAIT_V(6); PG8_BAR;
    for (;;) {
        const bool has_next = S.next(ui + 1, nxt);
        const char* nA = has_next ? nxt.A : cA; const char* nB = has_next ? nxt.B : cB;
        for (int t = 0; t < nt; t += 2) {
            const bool last = (t == nt - 2);
            const char* a1 = cA + (size_t)(t + 1) * kstep;
            const char* a2 = last ? nA : cA + (size_t)(t + 2) * kstep; const char* b2 = last ? nB : cB + (size_t)(t + 2) * kstep;
            const char* a3 = a2 + kstep; const char* b3 = b2 + kstep;
            PG8_LDB(B0, 0, 0); PG8_LDB(B1, 0, 1); PG8_SCHED; PG8_LDA(At, 0, 0); PG8_STAGE(PG8_SA(1, 1), a1 + hsA, voffA);
            PG8_WAIT_V(8); PG8_WAIT_L(0); PG8_BAR; PG8_MMA(0, 0, At, B0); PG8_MMA(0, 1, At, B1); PG8_BAR; PG8_SCHED;
            PG8_LDA(At, 0, 1); PG8_STAGE(PG8_SB(0, 0), b2, voffB); PG8_STAGE(PG8_SB(0, 1), b2 + hsB, voffB); PG8_STAGE(PG8_SA(0, 0), a2, voffA);
            PG8_WAIT_V(8); PG8_WAIT_L(0); PG8_BAR; PG8_MMA(1, 0, At, B0); PG8_MMA(1, 1, At, B1); PG8_BAR; PG8_SCHED;
            PG8_LDB(B0, 1, 0); PG8_LDB(B1, 1, 1); PG8_SCHED; PG8_LDA(At, 1, 0); PG8_STAGE(PG8_SA(0, 1), a2 + hsA, voffA);
            PG8_WAIT_V(8); PG8_WAIT_L(0); PG8_BAR; PG8_MMA(0, 0, At, B0); PG8_MMA(0, 1, At, B1); PG8_BAR; PG8_SCHED;
            PG8_LDA(At, 1, 1); PG8_STAGE(PG8_SB(1, 0), b3, voffB); PG8_STAGE(PG8_SB(1, 1), b3 + hsB, voffB); PG8_STAGE(PG8_SA(1, 0), a3, voffA);
            PG8_WAIT_V(8); PG8_WAIT_L(0); PG8_BAR; PG8_MMA(1, 0, At, B0); PG8_MMA(1, 1, At, B1); PG8_BAR; PG8_SCHED;
        }
        if (wr == 0) PG8_BAR;
        E(acc, cur, wr, wc, fr, fq);
        if (!has_next) break;
#pragma unroll
        for (int a = 0; a < 2; ++a)
#pragma unroll
            for (int b = 0; b < 2; ++b)
#pragma unroll
                for (int m = 0; m < 4; ++m)
#pragma unroll
                    for (int n = 0; n < 2; ++n) acc[a][b][m][n] = (f32x4){0.f, 0.f, 0.f, 0.f};
        cur = nxt; cA = nA; cB = nB; ++ui;
        if (wr == 1) PG8_BAR;
    }
    PG8_WAIT_V(0);
    PG8_BAR;
#undef PG8_SA
#undef PG8_SB
#undef PG8_STAGE
#undef PG8_LDA
#undef PG8_LDB
#undef PG8_MMA
#undef PG8_WAIT_V
#undef PG8_WAIT_L
#undef PG8_BAR
#undef PG8_SCHED
}
}
namespace att {
using bf16x8 = __attribute__((ext_vector_type(8))) short;
using s16x4  = __attribute__((ext_vector_type(4))) short;
using f32x16 = __attribute__((ext_vector_type(16))) float;
using u32x4  = __attribute__((ext_vector_type(4))) unsigned;
typedef unsigned short bf16_t;
constexpr int NW = 8, QBLK = 32, KVBLK = 64, DV = 128;
constexpr int SHM_V = KVBLK * DV * 2;
#define ATT_SBAR() __builtin_amdgcn_sched_barrier(0)
__device__ __forceinline__ int crow(int r, int hi) { return (r & 3) + 8 * (r >> 2) + 4 * hi; }
__device__ __forceinline__ unsigned cvtpk(float lo, float hi) { unsigned r; asm volatile("v_cvt_pk_bf16_f32 %0, %1, %2" : "=v"(r) : "v"(lo), "v"(hi)); return r; }

template <int SCALE_NUM>
struct SM {
  static constexpr float SCALE = (SCALE_NUM == 128) ? 0.088388347648318440f : 0.072168783648703220f;
  static constexpr float THR = 8.f;
  static __device__ __forceinline__ void partialSM(f32x16& p0, f32x16& p1, float& m_reg, float& mn, float& alpha) {
    constexpr float C = SCALE * 1.4426950408889634f;
    float pmax = p0[0];
#pragma unroll
    for (int r = 1; r < 16; ++r) pmax = fmaxf(pmax, p0[r]);
#pragma unroll
    for (int r = 0; r < 16; ++r) pmax = fmaxf(pmax, p1[r]);
    { auto rr = __builtin_amdgcn_permlane32_swap(__float_as_uint(pmax), __float_as_uint(pmax), false, false);
      pmax = fmaxf(__uint_as_float(rr[0]), __uint_as_float(rr[1])); }
    if (__builtin_expect(__all(pmax - m_reg <= THR / SCALE), 1)) { mn = m_reg; alpha = 1.f; }
    else { mn = fmaxf(m_reg, pmax); alpha = __builtin_amdgcn_exp2f((m_reg - mn) * C); m_reg = mn; }
    float mnC = -mn * C;
#pragma unroll
    for (int r = 0; r < 16; ++r) p0[r] = fmaf(p0[r], C, mnC);
#pragma unroll
    for (int r = 0; r < 16; ++r) p1[r] = fmaf(p1[r], C, mnC);
#pragma unroll
    for (int r = 0; r < 16; ++r) p0[r] = __builtin_amdgcn_exp2f(p0[r]);
  }
};
__device__ __forceinline__ void finishSM(f32x16& p0, f32x16& p1, float alpha, float& l_reg, bf16x8& pa0, bf16x8& pa1, bf16x8& pa2, bf16x8& pa3) {
#pragma unroll
  for (int r = 0; r < 16; ++r) p1[r] = __builtin_amdgcn_exp2f(p1[r]);
  float ps = 0;
#pragma unroll
  for (int r = 0; r < 16; ++r) ps += p0[r];
#pragma unroll
  for (int r = 0; r < 16; ++r) ps += p1[r];
  { auto rr = __builtin_amdgcn_permlane32_swap(__float_as_uint(ps), __float_as_uint(ps), false, false);
    ps = __uint_as_float(rr[0]) + __uint_as_float(rr[1]); }
  l_reg = l_reg * alpha + ps;
#define ATT_PK4(P, BASE, OUT) do { unsigned a0 = cvtpk(P[BASE + 0], P[BASE + 1]), a1 = cvtpk(P[BASE + 2], P[BASE + 3]);   \
    unsigned b0 = cvtpk(P[BASE + 4], P[BASE + 5]), b1 = cvtpk(P[BASE + 6], P[BASE + 7]);                              \
    auto r0 = __builtin_amdgcn_permlane32_swap(a0, b0, false, false); auto r1 = __builtin_amdgcn_permlane32_swap(a1, b1, false, false); \
    u32x4 w = {r0[0], r1[0], r0[1], r1[1]}; OUT = *reinterpret_cast<bf16x8*>(&w); } while (0)
  ATT_PK4(p0, 0, pa0); ATT_PK4(p0, 8, pa1); ATT_PK4(p1, 0, pa2); ATT_PK4(p1, 8, pa3);
#undef ATT_PK4
}
template <int DQK> __device__ __forceinline__ int kswz(int row, int colB) { return row * (DQK * 2) + (colB ^ ((row & 7) << 4)); }
template <int DQK> __device__ __forceinline__ void qkt(f32x16& p0, f32x16& p1, const char* Ks, const char* Ql, const bf16x8* qr, int r32, int hi) {
  p0 = f32x16{}; p1 = f32x16{};
#pragma unroll
  for (int d0 = 0; d0 < DQK / 16; ++d0) { const int cb = (d0 * 16 + hi * 8) * 2;
    if (DQK > 128 && d0 == 8) ATT_SBAR();
    bf16x8 b0 = *reinterpret_cast<const bf16x8*>(Ks + kswz<DQK>(r32, cb));
    bf16x8 b1 = *reinterpret_cast<const bf16x8*>(Ks + kswz<DQK>(32 + r32, cb));
    bf16x8 q; if (d0 < 8) q = qr[d0 < 8 ? d0 : 0]; else q = *reinterpret_cast<const bf16x8*>(Ql + (d0 - 8) * 1024);
    p0 = __builtin_amdgcn_mfma_f32_32x32x16_bf16(b0, q, p0, 0, 0, 0);
    p1 = __builtin_amdgcn_mfma_f32_32x32x16_bf16(b1, q, p1, 0, 0, 0); }
}
__device__ __forceinline__ int v_st(int k, int c) { const int kk = (k & ~0xC) | ((k & 4) << 1) | ((k & 8) >> 1); return ((kk >> 3) * 4 + (c >> 5)) * 512 + ((kk & 7) * 32 + (c & 31)) * 2; }
__device__ __forceinline__ int v_rd_base(int lane) { return ((lane & 3) << 3) | (((lane >> 2) & 3) << 6) | (((lane >> 4) & 1) << 5) | (((lane >> 5) & 1) << 8); }
constexpr int v_rd_off(int d0, int ks, int half) { return d0 * 512 + ks * 4096 + half * 2048; }
template <int OFF> __device__ __forceinline__ s16x4 tr_read(int vb) {
  s16x4 r; asm volatile("ds_read_b64_tr_b16 %0, %1 offset:%2" : "=&v"(r) : "v"(vb), "i"(OFF) : "memory"); return r;
}
template <int D0> __device__ __forceinline__ void pv_one(f32x16& od, int vb, bf16x8 pa0, bf16x8 pa1, bf16x8 pa2, bf16x8 pa3) {
  const s16x4 l0 = tr_read<v_rd_off(D0, 0, 0)>(vb), h0 = tr_read<v_rd_off(D0, 0, 1)>(vb), l1 = tr_read<v_rd_off(D0, 1, 0)>(vb), h1 = tr_read<v_rd_off(D0, 1, 1)>(vb);
  const s16x4 l2 = tr_read<v_rd_off(D0, 2, 0)>(vb), h2 = tr_read<v_rd_off(D0, 2, 1)>(vb), l3 = tr_read<v_rd_off(D0, 3, 0)>(vb), h3 = tr_read<v_rd_off(D0, 3, 1)>(vb);
  asm volatile("s_waitcnt lgkmcnt(0)" ::: "memory"); ATT_SBAR();
#define ATT_PK(L, H) (bf16x8){L[0], L[1], L[2], L[3], H[0], H[1], H[2], H[3]}
  od = __builtin_amdgcn_mfma_f32_32x32x16_bf16(pa0, ATT_PK(l0, h0), od, 0, 0, 0);
  od = __builtin_amdgcn_mfma_f32_32x32x16_bf16(pa1, ATT_PK(l1, h1), od, 0, 0, 0);
  od = __builtin_amdgcn_mfma_f32_32x32x16_bf16(pa2, ATT_PK(l2, h2), od, 0, 0, 0);
  od = __builtin_amdgcn_mfma_f32_32x32x16_bf16(pa3, ATT_PK(l3, h3), od, 0, 0, 0);
#undef ATT_PK
}
__device__ __forceinline__ void pv_d0(f32x16* o, int vb, bf16x8 pa0, bf16x8 pa1, bf16x8 pa2, bf16x8 pa3) {
  pv_one<0>(o[0], vb, pa0, pa1, pa2, pa3); pv_one<1>(o[1], vb, pa0, pa1, pa2, pa3); pv_one<2>(o[2], vb, pa0, pa1, pa2, pa3); pv_one<3>(o[3], vb, pa0, pa1, pa2, pa3);
}
__device__ __forceinline__ void store_o(float* p, float v) { *p = v; }
__device__ __forceinline__ void store_o(bf16_t* p, float v) { unsigned u = __float_as_uint(v); u = (u + 0x7fffu + ((u >> 16) & 1u)) >> 16; *p = (bf16_t)u; }

template <int DQK, int SCALE_NUM, bool LATE, typename TO>
__device__ __forceinline__ void attn_dense_body(const bf16_t* __restrict__ Qb, const bf16_t* __restrict__ Kh, const bf16_t* __restrict__ Vh,
                                                TO* __restrict__ Ob, int LDO, int seq, char* lds) {
  constexpr int SHM_K = KVBLK * DQK * 2, CPR = DQK / 8, NKC = (KVBLK * CPR) / 512;
  static_assert(NKC * 512 == KVBLK * CPR, "K staging");
  using S = SM<SCALE_NUM>;
  int tid_ = threadIdx.x; asm volatile("" : "+v"(tid_));
  const int tid = tid_, wid = tid >> 6, lane = tid & 63, r32 = lane & 31, hi = lane >> 5;
  char* V_lds = lds; char* K_lds = lds + 2 * SHM_V;
  float* ws = (float*)(lds + 2 * SHM_V + 2 * SHM_K) + wid * 64; float* li_l = ws; float* al_l = ws + 32;
  char* Ql = lds + 2 * SHM_V + 2 * SHM_K + 2048 + wid * 4096 + lane * 16;
  float m_reg = -1e30f, l_reg = 0; f32x16 o[4] = {}; bf16x8 qr[8];
  const bf16_t* Qw = Qb + (long)(wid * QBLK + r32) * DQK + hi * 8;
#pragma unroll
  for (int d0 = 0; d0 < DQK / 16; ++d0) { const bf16x8 q = *reinterpret_cast<const bf16x8*>(Qw + d0 * 16);
    if (d0 < 8) qr[d0 < 8 ? d0 : 0] = q; else *reinterpret_cast<bf16x8*>(Ql + (d0 - 8) * 1024) = q; }
  const int sr = tid >> 4, sc = (tid & 15) * 8, vst0 = v_st(sr, sc), vst1 = v_st(32 + sr, sc);
  int krow[NKC], kcol[NKC];
#pragma unroll
  for (int i = 0; i < NKC; ++i) { const int ci = tid + i * 512; krow[i] = ci / CPR; kcol[i] = (ci % CPR) * 8; }
  const int vb0 = (int)(uintptr_t)V_lds + v_rd_base(lane);
  bf16x8 vs0, vs1, ks[NKC];
#define ATT_SLOAD(k0) do { vs0 = *reinterpret_cast<const bf16x8*>(&Vh[(long)((k0) + sr) * DV + sc]); vs1 = *reinterpret_cast<const bf16x8*>(&Vh[(long)((k0) + 32 + sr) * DV + sc]); \
    _Pragma("unroll") for (int _c = 0; _c < NKC; ++_c) ks[_c] = *reinterpret_cast<const bf16x8*>(&Kh[(long)((k0) + krow[_c]) * DQK + kcol[_c]]); } while (0)
#define ATT_SWRITE(b) do { *(bf16x8*)(V_lds + (b) * SHM_V + vst0) = vs0; *(bf16x8*)(V_lds + (b) * SHM_V + vst1) = vs1; \
    _Pragma("unroll") for (int _c = 0; _c < NKC; ++_c) *(bf16x8*)(K_lds + (b) * SHM_K + kswz<DQK>(krow[_c], kcol[_c] * 2)) = ks[_c]; } while (0)
#define ATT_RESC(a) do { if (__any((a) < 1.f)) { if (hi == 0) al_l[r32] = (a); asm volatile("s_waitcnt lgkmcnt(0)" ::: "memory"); \
    _Pragma("unroll") for (int d = 0; d < 4; ++d) _Pragma("unroll") for (int r = 0; r < 16; ++r) o[d][r] *= al_l[crow(r, hi)]; } } while (0)
  f32x16 p0, p1; float mn, al; bf16x8 pa0, pa1, pa2, pa3; const int NT = seq / KVBLK;
  ATT_SLOAD(0); asm volatile("s_waitcnt vmcnt(0)" ::: "memory"); ATT_SWRITE(0); __syncthreads();
  for (int j = 0; j < NT; ++j) {
    const int b = j & 1;
    if (!LATE) { if (j + 1 < NT) ATT_SLOAD((j + 1) * KVBLK); }
    ATT_SBAR(); qkt<DQK>(p0, p1, K_lds + b * SHM_K, Ql, qr, r32, hi);
    S::partialSM(p0, p1, m_reg, mn, al);
    ATT_RESC(al);
    finishSM(p0, p1, al, l_reg, pa0, pa1, pa2, pa3); ATT_SBAR();
    if (LATE) { if (j + 1 < NT) ATT_SLOAD((j + 1) * KVBLK); ATT_SBAR(); }
    pv_d0(o, vb0 + b * (int)SHM_V, pa0, pa1, pa2, pa3);
    if (j + 1 < NT) ATT_SWRITE(b ^ 1);
    __syncthreads();
  }
  if (hi == 0) li_l[r32] = l_reg; asm volatile("s_waitcnt lgkmcnt(0)" ::: "memory");
  float rli[16];
#pragma unroll
  for (int r = 0; r < 16; ++r) rli[r] = __builtin_amdgcn_rcpf(li_l[crow(r, hi)]);
  TO* Ow = Ob + (long)(wid * QBLK) * LDO;
#pragma unroll
  for (int r = 0; r < 16; ++r) { const int orow = crow(r, hi);
#pragma unroll
    for (int d0 = 0; d0 < 4; ++d0) store_o(&Ow[(long)orow * LDO + d0 * 32 + r32], o[d0][r] * rli[r]); }
#undef ATT_SLOAD
#undef ATT_SWRITE
#undef ATT_RESC
}
}
constexpr int NWAVES = 8;
constexpr int DM = 2048, CB = 32, CS = 256, DEPTH = 4, LB = 2, LS = 2048, PAST = 256, GRIDW = 64;
constexpr int MC = CB * CS, ML = LB * LS, M = MC + ML;
constexpr int LKV = LS + PAST;
constexpr int HA = 6, DHA = 128, WA = HA * 2 * DHA, WB = 512;
constexpr int NAB = 3 * WA + WB;
constexpr int HC = 16, QLORA = 1536, KVLORA = 512, ROPEC = 64, DQKC = 192, DVC = 128;
constexpr int NMLA = QLORA + KVLORA + ROPEC, NMLAP = 2304;
constexpr int NUQ = HC * DQKC, NUKV = HC * 256;
constexpr int DFF = 5632, NGU = 2 * DFF, NMOD = 9, MODW = NMOD * DM;
constexpr int MKV = M + LB * PAST;
constexpr float EPS = 1e-6f;
constexpr int KSPLIT = 8;
constexpr int MODKC = 16;

constexpr size_t OUT_YP = 0, OUT_YS = (size_t)MC * DM, OUT_DK = OUT_YS + (size_t)ML * DM, OUT_DV = OUT_DK + (size_t)CB * 2 * HA * CS * 256,
                 OUT_CKV = OUT_DV + (size_t)CB * 2 * HA * CS * 256, OUT_KPE = OUT_CKV + (size_t)CB * 2 * CS * KVLORA, OUT_END = OUT_KPE + (size_t)CB * 2 * CS * ROPEC;

constexpr size_t MiB = 1u << 20;
constexpr size_t al1(size_t x) { return (x + MiB - 1) / MiB * MiB; }
constexpr size_t WS_CTL = 0, CTL_ZERO_BYTES = MiB;
constexpr size_t WS_MODP = MiB;
constexpr size_t WS_MOD  = WS_MODP + al1((size_t)MODKC * 4 * 3 * MODW * 4);
constexpr size_t WS_TABD = WS_MOD + al1((size_t)4 * 3 * MODW * 4);
constexpr size_t WS_TABSC = WS_TABD + al1((size_t)1024 * 512 * 2);
constexpr size_t WS_TABSL = WS_TABSC + al1((size_t)256 * 512 * 2);
constexpr size_t WS_ROPE = WS_TABSL + al1((size_t)2048 * 4096 * 2);
constexpr size_t WS_WGU = WS_ROPE + MiB;
constexpr size_t WS_WD  = WS_WGU + al1((size_t)8 * NGU * DM * 2);
constexpr size_t WS_WINAB = WS_WD + al1((size_t)8 * DM * DFF * 2);
constexpr size_t WS_WOUTAB = WS_WINAB + al1((size_t)2 * NAB * DM * 2);
constexpr size_t WS_WINMLA = WS_WOUTAB + al1((size_t)2 * DM * DM * 2);
constexpr size_t WS_WUQ = WS_WINMLA + al1((size_t)2 * NMLAP * DM * 2);
constexpr size_t WS_WUKV = WS_WUQ + al1((size_t)2 * NUQ * QLORA * 2);
constexpr size_t WS_WO = WS_WUKV + al1((size_t)2 * NUKV * KVLORA * 2);
constexpr size_t WS_H = WS_WO + al1((size_t)2 * DM * DM * 2);
constexpr size_t WS_ACT = WS_H + al1((size_t)M * DM * 2);
constexpr size_t WS_AW = WS_ACT + al1((size_t)M * DFF * 2);
constexpr size_t WS_MIX = WS_AW + al1((size_t)M * DM * 2);
constexpr size_t WE_RAW = WS_MIX;
constexpr size_t WE_F   = WE_RAW + al1((size_t)M * 3 * WA * 2);
constexpr size_t WE_QC  = WE_F + al1((size_t)M * WB * 2);
constexpr size_t WE_QL  = WE_QC + al1((size_t)MC * WA * 2);
constexpr size_t WE_KC  = WE_QL + al1((size_t)ML * WA * 2);
constexpr size_t WE_KL  = WE_KC + al1((size_t)MC * WA * 2);
constexpr size_t WE_VC  = WE_KL + al1((size_t)LB * HA * 2 * LKV * 128 * 2);
constexpr size_t WE_VL  = WE_VC + al1((size_t)MC * WA * 2);
constexpr size_t WE_OATT = WE_VL + al1((size_t)LB * HA * 2 * LKV * 128 * 2);
constexpr size_t WE_YTC = WE_OATT + al1((size_t)2 * M * WA * 4);
constexpr size_t WE_YTL = WE_YTC + al1((size_t)CB * 512 * 512 * 2);
constexpr size_t WE_FOPC = WE_YTL + al1((size_t)LB * 512 * 4096 * 2);
constexpr size_t WE_FOPL = WE_FOPC + al1((size_t)MC * 512 * 4);
constexpr size_t WE_END = WE_FOPL + al1((size_t)KSPLIT * ML * 512 * 4);
constexpr size_t WO_RAWM = WS_MIX;
constexpr size_t WO_CQN = WO_RAWM + al1((size_t)M * NMLAP * 4);
constexpr size_t WO_CKVN = WO_CQN + al1((size_t)M * QLORA * 2);
constexpr size_t WO_QRAW = WO_CKVN + al1((size_t)MKV * KVLORA * 2);
constexpr size_t WO_KVRAW = WO_QRAW + al1((size_t)M * NUQ * 2);
constexpr size_t WO_QMC = WO_KVRAW + al1((size_t)MKV * NUKV * 2);
constexpr size_t WO_QML = WO_QMC + al1((size_t)MC * NUQ * 2);
constexpr size_t WO_KMC = WO_QML + al1((size_t)ML * NUQ * 2);
constexpr size_t WO_KML = WO_KMC + al1((size_t)MC * NUQ * 2);
constexpr size_t WO_VMC = WO_KML + al1((size_t)LB * HC * LKV * 192 * 2);
constexpr size_t WO_VML = WO_VMC + al1((size_t)MC * HC * 128 * 2);
constexpr size_t WO_END = WO_VML + al1((size_t)LB * HC * LKV * 128 * 2);
constexpr size_t WS_END = (WE_END > WO_END ? WE_END : WO_END);

constexpr int CW_BAR = 4096;

constexpr int RING_OFF = 0, RING_BYTES = 131072;
constexpr int LDSCTL_OFF = RING_BYTES, MISC_OFF = LDSCTL_OFF + 320;
constexpr int LDS_BYTES = 147456;

#define GAS __attribute__((address_space(1)))
#define LAS __attribute__((address_space(3)))
typedef unsigned short bf16;
typedef unsigned v4u __attribute__((ext_vector_type(4)));
typedef unsigned v2u __attribute__((ext_vector_type(2)));
typedef float f32x4 __attribute__((ext_vector_type(4)));
typedef float f32x2 __attribute__((ext_vector_type(2)));
#define LDS_WAIT() asm volatile("s_waitcnt lgkmcnt(0)" ::: "memory")
__device__ __forceinline__ unsigned f2bf(float f) { unsigned u = __builtin_bit_cast(unsigned, f); return (u + 0x7fffu + ((u >> 16) & 1u)) >> 16; }
__device__ __forceinline__ unsigned pk2(float lo, float hi) { return f2bf(lo) | (f2bf(hi) << 16); }
__device__ __forceinline__ float bf_lo(unsigned w) { return __builtin_bit_cast(float, w << 16); }
__device__ __forceinline__ float bf_hi(unsigned w) { return __builtin_bit_cast(float, w & 0xffff0000u); }

#define XB_TMO      128
#define XB_XCNT(j)  (256  + 64 * (j))
#define XB_XSUB(j)  (1280 + 64 * (j))
#define XB_XGEN(j)  (2304 + 64 * (j))
#define XB_TOP      3328
#define XB_TOPGEN   3392
#define XCD_BAR_WORDS 3456
#define XB_SPIN_CAP (1u << 18)
__device__ __forceinline__ unsigned xb_ld(unsigned* p)              { return __hip_atomic_load(p, __ATOMIC_RELAXED, __HIP_MEMORY_SCOPE_AGENT); }
__device__ __forceinline__ unsigned xb_add(unsigned* p, unsigned v) { return __hip_atomic_fetch_add(p, v, __ATOMIC_RELAXED, __HIP_MEMORY_SCOPE_AGENT); }
__device__ __forceinline__ unsigned xb_xcc_id() { return (unsigned)__builtin_amdgcn_s_getreg((3 << 11) | 20) & 0xFu; }
#define XB_SPIN(cond, bar) do { unsigned _sp = 0; while (cond) { __builtin_amdgcn_s_sleep(1); \
    if ((++_sp & 255u) == 0u) { if (xb_ld(&(bar)[XB_TMO])) break; if (_sp > XB_SPIN_CAP) { atomicAdd(&(bar)[XB_TMO], 1u); break; } } } } while (0)
struct XcdBarrier { unsigned* bar; unsigned x; volatile LAS unsigned* st; };
__device__ __forceinline__ XcdBarrier xcd_barrier_post(unsigned* bar, volatile LAS unsigned* st) {
    XcdBarrier b; b.bar = bar; b.x = xb_xcc_id(); b.st = st;
    if (threadIdx.x == 0) (void)xb_add(&bar[XB_XCNT(b.x)], 1u);
    return b;
}
__device__ __forceinline__ void xcd_barrier_complete(unsigned* bar, unsigned x, unsigned& nloc, unsigned& nx) {
    const unsigned G = gridDim.x * gridDim.y * gridDim.z;
    unsigned sum, cnt, mine, sp = 0u;
    for (;;) {
        sum = 0u; cnt = 0u; mine = 0u;
#pragma unroll
        for (unsigned j = 0; j < 16; ++j) { const unsigned c = xb_ld(&bar[XB_XCNT(j)]); sum += c; cnt += (c > 0u) ? 1u : 0u; mine = (j == x) ? c : mine; }
        if (sum == G) break;
        __builtin_amdgcn_s_sleep(1);
        if ((++sp & 255u) == 0u) { if (xb_ld(&bar[XB_TMO])) break; if (sp > XB_SPIN_CAP) { atomicAdd(&bar[XB_TMO], 1u); break; } }
    }
    nloc = mine > 0u ? mine : 1u; nx = cnt > 0u ? cnt : 1u;
}
__device__ __forceinline__ void xcd_barrier(const XcdBarrier& b) {
    asm volatile("s_waitcnt vmcnt(0)" ::: "memory");
    __syncthreads();
    if (threadIdx.x == 0) {
        unsigned* bar = b.bar;
        __builtin_amdgcn_s_waitcnt(0);
        unsigned nloc = b.st[0], nx = b.st[1];
        if (nloc == 0u) { xcd_barrier_complete(bar, b.x, nloc, nx); b.st[0] = nloc; b.st[1] = nx; }
        const unsigned old = xb_add(&bar[XB_XSUB(b.x)], 1u);
        const unsigned gen = old / nloc;
        if (old + 1u == (gen + 1u) * nloc) {
            __builtin_amdgcn_fence(__ATOMIC_RELEASE, "agent");
            asm volatile("s_waitcnt vmcnt(0)" ::: "memory");
            const unsigned og = xb_add(&bar[XB_TOP], 1u);
            const unsigned tg = og / nx;
            if (og + 1u == (tg + 1u) * nx) xb_add(&bar[XB_TOPGEN], 1u);
            else XB_SPIN(xb_ld(&bar[XB_TOPGEN]) == tg, bar);
            __builtin_amdgcn_fence(__ATOMIC_ACQUIRE, "agent");
            xb_add(&bar[XB_XGEN(b.x)], 1u);
            asm volatile("s_waitcnt vmcnt(0)" ::: "memory");
        } else {
            XB_SPIN(xb_ld(&bar[XB_XGEN(b.x)]) == gen, bar);
            __builtin_amdgcn_fence(__ATOMIC_ACQUIRE, "agent");
            asm volatile("s_waitcnt vmcnt(0)" ::: "memory");
        }
    }
    __syncthreads();
}

struct Args { const float* in[26]; float* out; unsigned char* ws; int ph_lo, ph_hi; };
typedef const __attribute__((address_space(4))) Args CArgs;
__device__ __forceinline__ CArgs* kargs() { CArgs* p = (CArgs*)__builtin_amdgcn_kernarg_segment_ptr(); asm volatile("" : "+s"(p)); return p; }
enum { I_XP = 0, I_XS, I_C, I_CDK, I_CDV, I_CCKV, I_CKPE, I_CCTX, I_WMOD, I_BMOD, I_GNORM, I_WG, I_WU, I_WDN, I_WINAB, I_WOUTAB, I_GQKD, I_LAM, I_GSUB,
       I_WINMLA, I_GQL, I_WUQ, I_GKVL, I_WUKV, I_GQKM, I_WOM };

__device__ __forceinline__ float wave_sum(float v) {
#pragma unroll
    for (int o = 1; o < 64; o <<= 1) v += __shfl_xor(v, o);
    return v;
}
__device__ __forceinline__ float half_sum(float v) {
#pragma unroll
    for (int o = 1; o < 32; o <<= 1) v += __shfl_xor(v, o);
    return v;
}
__device__ __forceinline__ int cond_of_row(int r) { return r < MC ? 0 : 1 + (r - MC) / LS; }
__device__ __forceinline__ int cond_of_pm(int pm) { return pm < CB ? 0 : 1 + (pm - CB) / (LS / 256); }
using pg8::Unit;
typedef const pg8::f32x4 (&AccRef)[2][2][4][2];

__device__ __forceinline__ float silu_f(float g) { return g * __builtin_amdgcn_rcpf(1.0f + __builtin_amdgcn_exp2f(-1.4426950408889634f * g)); }

struct EpiSwiglu {
    static constexpr bool PERM = true;
    bf16* O;
    __device__ __forceinline__ void operator()(AccRef acc, const Unit& u, int wr, int wc, int fr, int fq) const {
        const int row0 = u.pm * 256 + wr * 64 + fr, col0 = u.pn * 128 + wc * 32 + 8 * fq;
#pragma unroll
        for (int ai = 0; ai < 2; ++ai)
#pragma unroll
            for (int m = 0; m < 4; ++m) {
                bf16* rowp = O + (size_t)(row0 + ai * 128 + m * 16) * DFF + col0;
                const pg8::f32x4 g0 = acc[ai][0][m][0], g1 = acc[ai][0][m][1], u0 = acc[ai][1][m][0], u1 = acc[ai][1][m][1];
                v4u w;
                w.x = pg8::cvt_pk_bf16(silu_f(g0[0]) * u0[0], silu_f(g0[1]) * u0[1]); w.y = pg8::cvt_pk_bf16(silu_f(g0[2]) * u0[2], silu_f(g0[3]) * u0[3]);
                w.z = pg8::cvt_pk_bf16(silu_f(g1[0]) * u1[0], silu_f(g1[1]) * u1[1]); w.w = pg8::cvt_pk_bf16(silu_f(g1[2]) * u1[2], silu_f(g1[3]) * u1[3]);
                *(v4u*)rowp = w;
            }
    }
};
struct EpiResid {
    static constexpr bool PERM = false;
    const float* xin_c; const float* xin_l;
    float* xout;
    const float* gate;
    float scale;
    __device__ __forceinline__ void operator()(AccRef acc, const Unit& u, int wr, int wc, int fr, int fq) const {
        const int cond = cond_of_pm(u.pm);
        const float* gp = gate + (size_t)cond * MODW;
        const int row0 = u.pm * 256 + wr * 64 + fr, col0 = u.pn * 256 + wc * 32 + 4 * fq;
        const float* xin = (u.pm < CB) ? xin_c + (size_t)row0 * DM : xin_l + (size_t)(row0 - MC) * DM;
        pg8::f32x4 gv[2][2];
#pragma unroll
        for (int bj = 0; bj < 2; ++bj)
#pragma unroll
            for (int n = 0; n < 2; ++n) gv[bj][n] = *(const pg8::f32x4*)(gp + col0 + bj * 128 + n * 16) * scale;
#pragma unroll
        for (int ai = 0; ai < 2; ++ai)
#pragma unroll
            for (int m = 0; m < 4; ++m) {
                const size_t ro = (size_t)(ai * 128 + m * 16) * DM;
                float* op = xout + (size_t)row0 * DM + ro;
#pragma unroll
                for (int bj = 0; bj < 2; ++bj)
#pragma unroll
                    for (int n = 0; n < 2; ++n) { const int c = col0 + bj * 128 + n * 16;
                        const pg8::f32x4 xi = *(const pg8::f32x4*)(xin + ro + c);
                        *(pg8::f32x4*)(op + c) = xi + gv[bj][n] * acc[ai][bj][m][n]; }
            }
    }
};
struct EpiBf16 {
    static constexpr bool PERM = true;
    bf16* O1; int ld1; int split; bf16* O2; int ld2;
    __device__ __forceinline__ void operator()(AccRef acc, const Unit& u, int wr, int wc, int fr, int fq) const {
        const int row0 = u.pm * 256 + wr * 64 + fr; int colt = u.pn * 256; bf16* base = O1; int ld = ld1;
        if (colt >= split) { base = O2; ld = ld2; colt -= split; }
        const int col0 = colt + wc * 32 + 8 * fq;
#pragma unroll
        for (int ai = 0; ai < 2; ++ai)
#pragma unroll
            for (int m = 0; m < 4; ++m) { bf16* rowp = base + (size_t)(row0 + ai * 128 + m * 16) * ld + col0;
#pragma unroll
                for (int bj = 0; bj < 2; ++bj) { const pg8::f32x4 v0 = acc[ai][bj][m][0], v1 = acc[ai][bj][m][1];
                    v4u w; w.x = pg8::cvt_pk_bf16(v0[0], v0[1]); w.y = pg8::cvt_pk_bf16(v0[2], v0[3]); w.z = pg8::cvt_pk_bf16(v1[0], v1[1]); w.w = pg8::cvt_pk_bf16(v1[2], v1[3]);
                    *(v4u*)(rowp + bj * 128) = w; } }
    }
};
struct EpiF32 {
    static constexpr bool PERM = false;
    float* C; int ld; int tile_mode;
    __device__ __forceinline__ void operator()(AccRef acc, const Unit& u, int wr, int wc, int fr, int fq) const {
        float* base = tile_mode ? C + u.z : C + (size_t)u.pm * 256 * ld + u.pn * 256;
        const int row0 = wr * 64 + fr, col0 = wc * 32 + 4 * fq;
#pragma unroll
        for (int ai = 0; ai < 2; ++ai)
#pragma unroll
            for (int m = 0; m < 4; ++m) { float* rowp = base + (size_t)(row0 + ai * 128 + m * 16) * ld + col0;
#pragma unroll
                for (int bj = 0; bj < 2; ++bj)
#pragma unroll
                    for (int n = 0; n < 2; ++n) *(pg8::f32x4*)(rowp + bj * 128 + n * 16) = acc[ai][bj][m][n]; }
    }
};
struct EpiYt {
    static constexpr bool PERM = true;
    bf16* YTC; bf16* YTL;
    __device__ __forceinline__ void operator()(AccRef acc, const Unit& u, int wr, int wc, int fr, int fq) const {
        const int g = u.pm; bf16* base; int pitch, half, s0;
        if (u.pn < CB) { base = YTC + (size_t)(u.pn * 512 + g * 128) * 512; pitch = 512; half = 256; s0 = 0; }
        else { const int q = u.pn - CB; base = YTL + (size_t)((q >> 3) * 512 + g * 128) * 4096; pitch = 4096; half = 2048; s0 = (q & 7) * 256; }
        const int col0 = s0 + wc * 32 + 8 * fq;
#pragma unroll
        for (int ai = 0; ai < 2; ++ai)
#pragma unroll
            for (int m = 0; m < 4; ++m) { const int j = wr * 64 + m * 16 + fr; bf16* rowp = base + (size_t)j * pitch + ai * half + col0;
#pragma unroll
                for (int bj = 0; bj < 2; ++bj) { const pg8::f32x4 v0 = acc[ai][bj][m][0], v1 = acc[ai][bj][m][1];
                    v4u w; w.x = pg8::cvt_pk_bf16(v0[0], v0[1]); w.y = pg8::cvt_pk_bf16(v0[2], v0[3]); w.z = pg8::cvt_pk_bf16(v1[0], v1[1]); w.w = pg8::cvt_pk_bf16(v1[2], v1[3]);
                    *(v4u*)(rowp + bj * 128) = w; } }
    }
};
__device__ __forceinline__ void transpose_item(const float* W, int ldn, int k0, int n0, bf16* WT, int ldk, int drow0, LAS float* scr, int lane) {
#pragma unroll 16
    for (int i = 0; i < 32; ++i) { const int kk = 2 * i + (lane >> 5); scr[kk * 33 + (lane & 31)] = W[(size_t)(k0 + kk) * ldn + n0 + (lane & 31)]; }
    LDS_WAIT(); asm volatile("" ::: "memory");
    const int c = lane & 7;
#pragma unroll
    for (int j = 0; j < 4; ++j) { const int n = (lane >> 3) + 8 * j; const LAS float* s = scr + (8 * c) * 33 + n;
        v4u o; o.x = pk2(s[0 * 33], s[1 * 33]); o.y = pk2(s[2 * 33], s[3 * 33]); o.z = pk2(s[4 * 33], s[5 * 33]); o.w = pk2(s[6 * 33], s[7 * 33]);
        *(v4u*)(WT + (size_t)(drow0 + n) * ldk + k0 + 8 * c) = o; }
    LDS_WAIT(); asm volatile("" ::: "memory");
}
struct MatDesc { const float* src; bf16* dst; int K, N, mode; };
__device__ __forceinline__ MatDesc get_mat(CArgs& a, int mi) {
    MatDesc d; unsigned char* ws = a.ws;
    if (mi < 24) { const int f = mi / 3, t = mi % 3;
        if (t == 0)      { d.src = a.in[I_WG] + (size_t)f * DM * DFF; d.dst = (bf16*)(ws + WS_WGU) + (size_t)f * NGU * DM; d.K = DM; d.N = DFF; d.mode = 1; }
        else if (t == 1) { d.src = a.in[I_WU] + (size_t)f * DM * DFF; d.dst = (bf16*)(ws + WS_WGU) + (size_t)f * NGU * DM; d.K = DM; d.N = DFF; d.mode = 2; }
        else             { d.src = a.in[I_WDN] + (size_t)f * DFF * DM; d.dst = (bf16*)(ws + WS_WD) + (size_t)f * DM * DFF; d.K = DFF; d.N = DM; d.mode = 0; }
    } else if (mi < 28) { const int e = (mi - 24) / 2, t = (mi - 24) % 2;
        if (t == 0) { d.src = a.in[I_WINAB] + (size_t)e * DM * NAB; d.dst = (bf16*)(ws + WS_WINAB) + (size_t)e * NAB * DM; d.K = DM; d.N = NAB; d.mode = 0; }
        else        { d.src = a.in[I_WOUTAB] + (size_t)e * DM * DM; d.dst = (bf16*)(ws + WS_WOUTAB) + (size_t)e * DM * DM; d.K = DM; d.N = DM; d.mode = 0; }
    } else { const int o = (mi - 28) / 4, t = (mi - 28) % 4;
        if (t == 0)      { d.src = a.in[I_WINMLA] + (size_t)o * DM * NMLA; d.dst = (bf16*)(ws + WS_WINMLA) + (size_t)o * NMLAP * DM; d.K = DM; d.N = NMLA; d.mode = 0; }
        else if (t == 1) { d.src = a.in[I_WUQ] + (size_t)o * QLORA * NUQ; d.dst = (bf16*)(ws + WS_WUQ) + (size_t)o * NUQ * QLORA; d.K = QLORA; d.N = NUQ; d.mode = 0; }
        else if (t == 2) { d.src = a.in[I_WUKV] + (size_t)o * KVLORA * NUKV; d.dst = (bf16*)(ws + WS_WUKV) + (size_t)o * NUKV * KVLORA; d.K = KVLORA; d.N = NUKV; d.mode = 0; }
        else             { d.src = a.in[I_WOM] + (size_t)o * DM * DM; d.dst = (bf16*)(ws + WS_WO) + (size_t)o * DM * DM; d.K = DM; d.N = DM; d.mode = 0; }
    }
    return d;
}
constexpr int N_MATS = 36;
constexpr int MOD_CB = MODW / 256;
constexpr int N_MOD_ITEMS = DEPTH * MODKC * MOD_CB;

__device__ __forceinline__ float silu_precise(float x) { return x / (1.0f + expf(-x)); }

__device__ __forceinline__ void phase_prologue(CArgs& a, LAS unsigned char* lds, int gw, int NGW, int wave, int lane) {
    asm volatile("" : "+v"(lane));
    unsigned char* ws = a.ws;
    {
        LAS float* sl = (LAS float*)(lds + RING_OFF + wave * 16384);
        float* modp = (float*)(ws + WS_MODP);
        for (int it = gw; it < N_MOD_ITEMS; it += NGW) {
            const int cb = it % MOD_CB, kc = (it / MOD_CB) % MODKC, l = it / (MOD_CB * MODKC);
            const int k0 = kc * 128;
#pragma unroll
            for (int h = 0; h < 2; ++h) { const int k = k0 + lane + 64 * h;
                sl[0 * 128 + lane + 64 * h] = silu_precise(a.in[I_CCTX][k]);
                sl[1 * 128 + lane + 64 * h] = silu_precise(a.in[I_C][k]);
                sl[2 * 128 + lane + 64 * h] = silu_precise(a.in[I_C][DM + k]); }
            LDS_WAIT(); asm volatile("" ::: "memory");
            const float* wp = a.in[I_WMOD] + ((size_t)l * DM + k0) * MODW + cb * 256 + lane * 4;
            f32x4 acc0 = {0.f, 0.f, 0.f, 0.f}, acc1 = acc0, acc2 = acc0;
#pragma unroll 8
            for (int k = 0; k < 128; ++k) { const f32x4 w = *(const f32x4*)(wp + (size_t)k * MODW);
                acc0 += w * sl[k]; acc1 += w * sl[128 + k]; acc2 += w * sl[256 + k]; }
            float* op = modp + ((size_t)(kc * DEPTH + l) * 3) * MODW + cb * 256 + lane * 4;
            *(f32x4*)(op) = acc0; *(f32x4*)(op + MODW) = acc1; *(f32x4*)(op + 2 * MODW) = acc2;
            LDS_WAIT(); asm volatile("" ::: "memory");
        }
    }
    {
        LAS float* scr = (LAS float*)(lds + RING_OFF + wave * 16384);
        int base = N_MOD_ITEMS % NGW;
        for (int mi = 0; mi < N_MATS; ++mi) {
            const MatDesc d = get_mat(a, mi);
            const int nblk = d.N / 32, nitems = (d.K / 64) * nblk;
            int first = gw - base; if (first < 0) first += NGW;
            for (int it = first; it < nitems; it += NGW) {
                const int kb = it / nblk, nb = it % nblk, n0 = nb * 32;
                const int drow0 = d.mode == 0 ? n0 : ((n0 >> 7) * 256 + (n0 & 127) + (d.mode == 2 ? 128 : 0));
                transpose_item(d.src, d.N, kb * 64, n0, d.dst, d.K, drow0, scr, lane);
            }
            base = (base + nitems) % NGW;
        }
    }
    {
        const size_t gt = (size_t)gw * 64 + lane, NGT = (size_t)NGW * 64;
        for (size_t i = gt; i < (size_t)2 * (NMLAP - NMLA) * DM / 8; i += NGT) { const size_t o = i / ((size_t)(NMLAP - NMLA) * DM / 8), r = i % ((size_t)(NMLAP - NMLA) * DM / 8);
            *((v4u*)((bf16*)(ws + WS_WINMLA) + o * NMLAP * DM + (size_t)NMLA * DM) + r) = (v4u){0u, 0u, 0u, 0u}; }
        for (size_t i = gt; i < (size_t)1024 * 512 / 2; i += NGT) { const int r = (int)(i / 256), c0 = (int)(i % 256) * 2; const int g = r >> 8, cs = (r >> 7) & 1, j = r & 127;
            float v[2];
#pragma unroll
            for (int t = 0; t < 2; ++t) { const int c = c0 + t, g2 = c >> 7, d = c & 127; const float x = (float)((j * d) & 127) * (1.0f / 64.0f);
                v[t] = (g2 == g) ? (cs ? sinpif(x) : cospif(x)) : 0.f; }
            ((unsigned*)(ws + WS_TABD))[i] = pk2(v[0], v[1]); }
        for (size_t i = gt; i < (size_t)256 * 512 / 2; i += NGT) { const int k = (int)(i / 256), c0 = (int)(i % 256) * 2; float v[2];
#pragma unroll
            for (int t = 0; t < 2; ++t) { const int c = c0 + t, sn = c >> 8, s = c & 255; const float x = (float)((k * s) & 255) * (1.0f / 128.0f);
                v[t] = (sn ? -sinpif(x) : cospif(x)) * 0.005524271728019903f; }
            ((unsigned*)(ws + WS_TABSC))[i] = pk2(v[0], v[1]); }
        for (size_t i = gt; i < (size_t)2048 * 4096 / 2; i += NGT) { const int k = (int)(i / 2048), c0 = (int)(i % 2048) * 2; float v[2];
#pragma unroll
            for (int t = 0; t < 2; ++t) { const int c = c0 + t, sn = c >> 11, s = c & 2047; const float x = (float)((k * s) & 2047) * (1.0f / 1024.0f);
                v[t] = (sn ? -sinpif(x) : cospif(x)) * 0.001953125f; }
            ((unsigned*)(ws + WS_TABSL))[i] = pk2(v[0], v[1]); }
        float* ropeA = (float*)(ws + WS_ROPE); float* ropeC = ropeA + 96 * 32 * 2;
        for (size_t i = gt; i < 96 * 32; i += NGT) { const int p = (int)i / 32, ii = (int)i % 32; const float pos = (float)(p < 32 ? p : p - 32);
            const float inv = powf(10000.0f, -(float)(2 * ii) / 64.0f); const float ang = pos * inv; ropeA[2 * i] = cosf(ang); ropeA[2 * i + 1] = sinf(ang); }
        for (size_t i = gt; i < 96 * 16; i += NGT) { const int p = (int)i / 16, ii = (int)i % 16; const float pos = (float)(p < 32 ? p : p - 32);
            const float inv = powf(10000.0f, -(float)(2 * ii) / 32.0f); const float ang = pos * inv; ropeC[2 * i] = cosf(ang); ropeC[2 * i + 1] = sinf(ang); }
    }
}
__device__ __forceinline__ void phase_modreduce(CArgs& a, int gw, int NGW, int lane) {
    asm volatile("" : "+v"(lane));
    const float* modp = (const float*)(a.ws + WS_MODP); float* mod = (float*)(a.ws + WS_MOD);
    const size_t NV = (size_t)DEPTH * 3 * MODW / 4;
    for (size_t i = (size_t)gw * 64 + lane; i < NV; i += (size_t)NGW * 64) {
        const size_t e = i * 4; const int l = (int)(e / (3 * MODW)), n = (int)(e % MODW);
        f32x4 s = *(const f32x4*)(a.in[I_BMOD] + (size_t)l * MODW + n);
#pragma unroll
        for (int kc = 0; kc < MODKC; ++kc) s += *(const f32x4*)(modp + (size_t)kc * DEPTH * 3 * MODW + e);
        *(f32x4*)(mod + e) = s;
    }
}

__device__ __forceinline__ void phase_norm(CArgs& a, int l, int ni, bool first, int gw, int NGW, int lane) {
    asm volatile("" : "+v"(lane));
    const float* mod = (const float*)(a.ws + WS_MOD); bf16* H = (bf16*)(a.ws + WS_H);
    const float* gn = a.in[I_GNORM] + (size_t)(l * 3 + ni) * DM;
    for (int row = gw; row < M; row += NGW) {
        const float* xr = first ? (row < MC ? a.in[I_XP] + (size_t)row * DM : a.in[I_XS] + (size_t)(row - MC) * DM) : a.out + (size_t)row * DM;
        f32x4 v[8]; float ss = 0.f;
#pragma unroll
        for (int j = 0; j < 8; ++j) { v[j] = *(const f32x4*)(xr + j * 256 + lane * 4); ss += (v[j][0] * v[j][0] + v[j][1] * v[j][1]) + (v[j][2] * v[j][2] + v[j][3] * v[j][3]); }
        const float rstd = 1.0f / sqrtf(wave_sum(ss) * (1.0f / DM) + EPS);
        const float* mp = mod + (size_t)(l * 3 + cond_of_row(row)) * MODW;
#pragma unroll
        for (int j = 0; j < 8; ++j) { const int c = j * 256 + lane * 4;
            const f32x4 g = *(const f32x4*)(gn + c), sh = *(const f32x4*)(mp + (3 * ni) * DM + c), sc = *(const f32x4*)(mp + (3 * ni + 1) * DM + c);
            const f32x4 h = (v[j] * rstd) * g * (sc + 1.0f) + sh;
            v2u w; w.x = pk2(h[0], h[1]); w.y = pk2(h[2], h[3]);
            *(v2u*)(H + (size_t)row * DM + c) = w; }
    }
}

__device__ __forceinline__ void phase_even_post(CArgs& a, int e, int gw, int NGW, int lane) {
    asm volatile("" : "+v"(lane));
    unsigned char* ws = a.ws;
    const bf16* RAW = (const bf16*)(ws + WE_RAW);
    bf16 *QC = (bf16*)(ws + WE_QC), *QL = (bf16*)(ws + WE_QL), *KC = (bf16*)(ws + WE_KC), *KL = (bf16*)(ws + WE_KL), *VC = (bf16*)(ws + WE_VC), *VL = (bf16*)(ws + WE_VL);
    const float* ropeA = (const float*)(ws + WS_ROPE);
    const int half = lane >> 5, l32 = lane & 31;
    const f32x4 gq = *(const f32x4*)(a.in[I_GQKD] + (size_t)(e * 2 + 0) * DHA + 4 * l32), gk = *(const f32x4*)(a.in[I_GQKD] + (size_t)(e * 2 + 1) * DHA + 4 * l32);
    for (int row = gw; row < M; row += NGW) {
        const bool lat = row >= MC; const int b = lat ? (row - MC) / LS : row / CS, s = lat ? (row - MC) % LS : row % CS;
        const int part = l32 >> 4, p = part ? 32 + (s % GRIDW) : (s / GRIDW), i0 = (4 * l32) & 31; const bool firsth = (l32 & 8) == 0;
        f32x4 cs4 = {1.f, 1.f, 1.f, 1.f}, sn4 = {0.f, 0.f, 0.f, 0.f};
        if (lat) {
#pragma unroll
            for (int k = 0; k < 4; ++k) { const f32x2 t = *(const f32x2*)(ropeA + ((size_t)p * 32 + i0 + k) * 2); cs4[k] = t[0]; sn4[k] = firsth ? -t[1] : t[1]; } }
#pragma unroll 2
        for (int it = 0; it < 18; ++it) {
            const int v = 2 * it + half;
            const v2u w = *(const v2u*)(RAW + (size_t)row * (3 * WA) + v * 128 + 4 * l32);
            f32x4 x = {bf_lo(w.x), bf_hi(w.x), bf_lo(w.y), bf_hi(w.y)};
            const int kind = v / 12, hv = v % 12, h = hv >> 1, c = hv & 1;
            if (it < 12) {
                const float ss = half_sum((x[0] * x[0] + x[1] * x[1]) + (x[2] * x[2] + x[3] * x[3]));
                const float rstd = 1.0f / sqrtf(ss * (1.0f / DHA) + EPS);
                x = x * rstd * (kind == 0 ? gq : gk);
                if (kind == 1 && !lat) *(f32x4*)(a.out + OUT_DK + ((((size_t)b * 2 + e) * HA + h) * CS + s) * 256 + c * 128 + 4 * l32) = x;
                f32x4 xp;
#pragma unroll
                for (int k = 0; k < 4; ++k) xp[k] = __shfl_xor(x[k], 8);
                x = x * cs4 + xp * sn4;
            } else if (!lat) *(f32x4*)(a.out + OUT_DV + ((((size_t)b * 2 + e) * HA + h) * CS + s) * 256 + c * 128 + 4 * l32) = x;
            v2u o; o.x = pk2(x[0], x[1]); o.y = pk2(x[2], x[3]);
            const size_t bh = ((size_t)b * HA + h) * 2 + c;
            bf16* dst;
            if (kind == 0) dst = lat ? QL + (bh * LS + s) * 128 : QC + (bh * CS + s) * 128;
            else if (kind == 1) dst = lat ? KL + (bh * LKV + s) * 128 : KC + (bh * CS + s) * 128;
            else dst = lat ? VL + (bh * LKV + s) * 128 : VC + (bh * CS + s) * 128;
            *(v2u*)(dst + 4 * l32) = o;
        }
    }
    for (int it = gw; it < 2 * LB * HA * PAST; it += NGW) {
        const int t = it % PAST, h = (it / PAST) % HA, b = (it / (PAST * HA)) % LB, kv = it / (PAST * HA * LB);
        const float* src = a.in[kv ? I_CDV : I_CDK] + ((((size_t)b * 2 + e) * HA + h) * PAST + t) * 256 + lane * 4;
        const f32x4 x = *(const f32x4*)src; v2u o; o.x = pk2(x[0], x[1]); o.y = pk2(x[2], x[3]);
        const int c = lane >> 5; bf16* dst = (kv ? VL : KL) + ((((size_t)b * HA + h) * 2 + c) * LKV + LS + t) * 128 + 4 * (lane & 31);
        *(v2u*)dst = o;
    }
}
__device__ __forceinline__ void phase_even_combine(CArgs& a, int e, int gw, int NGW, int lane) {
    asm volatile("" : "+v"(lane));
    unsigned char* ws = a.ws;
    const float* O0 = (const float*)(ws + WE_OATT); const float* O1 = O0 + (size_t)M * WA;
    const float* FC = (const float*)(ws + WE_FOPC); const float* FL = (const float*)(ws + WE_FOPL);
    bf16* AW = (bf16*)(ws + WS_AW);
    const float* lv = a.in[I_LAM] + (size_t)e * 4 * DHA;
    const float d1 = wave_sum(lv[lane] * lv[128 + lane] + lv[64 + lane] * lv[192 + lane]);
    const float d2 = wave_sum(lv[256 + lane] * lv[384 + lane] + lv[320 + lane] * lv[448 + lane]);
    const float lam_init = 0.8f - 0.6f * expf(-0.3f * (float)(2 * e));
    const float lam = expf(d1) - expf(d2) + lam_init;
    const f32x4 gs = *(const f32x4*)(a.in[I_GSUB] + (size_t)e * 256 + lane * 4) * (1.0f - lam_init);
    for (int row = gw; row < M; row += NGW) {
#pragma unroll
        for (int h = 0; h < HA; ++h) {
            const size_t o = (size_t)row * WA + h * 256 + lane * 4;
            const f32x4 d = *(const f32x4*)(O0 + o) - *(const f32x4*)(O1 + o) * lam;
            const float ss = wave_sum((d[0] * d[0] + d[1] * d[1]) + (d[2] * d[2] + d[3] * d[3]));
            const float rstd = 1.0f / sqrtf(ss * (1.0f / 256.0f) + EPS);
            const f32x4 y = d * rstd * gs;
            v2u w; w.x = pk2(y[0], y[1]); w.y = pk2(y[2], y[3]);
            *(v2u*)(AW + (size_t)row * DM + h * 256 + lane * 4) = w;
        }
        f32x4 f0, f1;
        if (row < MC) { const float* p = FC + (size_t)row * 512 + lane * 8; f0 = *(const f32x4*)p; f1 = *(const f32x4*)(p + 4); }
        else { f0 = (f32x4){0.f, 0.f, 0.f, 0.f}; f1 = f0;
#pragma unroll
            for (int ks = 0; ks < KSPLIT; ++ks) { const float* p = FL + ((size_t)ks * ML + (row - MC)) * 512 + lane * 8; f0 += *(const f32x4*)p; f1 += *(const f32x4*)(p + 4); } }
        v4u w; w.x = pk2(f0[0], f0[1]); w.y = pk2(f0[2], f0[3]); w.z = pk2(f1[0], f1[1]); w.w = pk2(f1[2], f1[3]);
        *(v4u*)(AW + (size_t)row * DM + WA + lane * 8) = w;
    }
}
__device__ __forceinline__ void phase_odd_post1(CArgs& a, int o, int gw, int NGW, int lane) {
    asm volatile("" : "+v"(lane));
    unsigned char* ws = a.ws;
    const float* RAWM = (const float*)(ws + WO_RAWM); bf16* CQN = (bf16*)(ws + WO_CQN); bf16* CKVN = (bf16*)(ws + WO_CKVN);
    const float* gql = a.in[I_GQL] + (size_t)o * QLORA; const float* gkv = a.in[I_GKVL] + (size_t)o * KVLORA;
    for (int row = gw; row < MKV; row += NGW) {
        if (row >= M) {
            const int b = (row - M) / PAST, t = (row - M) % PAST;
            const float* src = a.in[I_CCKV] + (((size_t)b * 2 + o) * PAST + t) * KVLORA + lane * 8;
            const f32x4 x0 = *(const f32x4*)src, x1 = *(const f32x4*)(src + 4);
            v4u w; w.x = pk2(x0[0], x0[1]); w.y = pk2(x0[2], x0[3]); w.z = pk2(x1[0], x1[1]); w.w = pk2(x1[2], x1[3]);
            *(v4u*)(CKVN + (size_t)row * KVLORA + lane * 8) = w; continue; }
        const float* r = RAWM + (size_t)row * NMLAP;
        f32x4 q[6]; float ss = 0.f;
#pragma unroll
        for (int j = 0; j < 6; ++j) { q[j] = *(const f32x4*)(r + j * 256 + lane * 4); ss += (q[j][0] * q[j][0] + q[j][1] * q[j][1]) + (q[j][2] * q[j][2] + q[j][3] * q[j][3]); }
        const float rq = 1.0f / sqrtf(wave_sum(ss) * (1.0f / QLORA) + EPS);
#pragma unroll
        for (int j = 0; j < 6; ++j) { const f32x4 y = q[j] * rq * *(const f32x4*)(gql + j * 256 + lane * 4); v2u w; w.x = pk2(y[0], y[1]); w.y = pk2(y[2], y[3]);
            *(v2u*)(CQN + (size_t)row * QLORA + j * 256 + lane * 4) = w; }
        f32x4 kv0 = *(const f32x4*)(r + QLORA + lane * 8), kv1 = *(const f32x4*)(r + QLORA + lane * 8 + 4);
        const float s2 = wave_sum((kv0[0] * kv0[0] + kv0[1] * kv0[1]) + (kv0[2] * kv0[2] + kv0[3] * kv0[3]) + (kv1[0] * kv1[0] + kv1[1] * kv1[1]) + (kv1[2] * kv1[2] + kv1[3] * kv1[3]));
        const float rk = 1.0f / sqrtf(s2 * (1.0f / KVLORA) + EPS);
        kv0 = kv0 * rk * *(const f32x4*)(gkv + lane * 8); kv1 = kv1 * rk * *(const f32x4*)(gkv + lane * 8 + 4);
        v4u w; w.x = pk2(kv0[0], kv0[1]); w.y = pk2(kv0[2], kv0[3]); w.z = pk2(kv1[0], kv1[1]); w.w = pk2(kv1[2], kv1[3]);
        *(v4u*)(CKVN + (size_t)row * KVLORA + lane * 8) = w;
        if (row < MC) { const int b = row / CS, s = row % CS;
            float* oc = a.out + OUT_CKV + (((size_t)b * 2 + o) * CS + s) * KVLORA + lane * 8; *(f32x4*)oc = kv0; *(f32x4*)(oc + 4) = kv1;
            if (lane < 16) *(f32x4*)(a.out + OUT_KPE + (((size_t)b * 2 + o) * CS + s) * ROPEC + lane * 4) = *(const f32x4*)(r + QLORA + KVLORA + lane * 4); }
    }
}
__device__ __forceinline__ void phase_odd_post2(CArgs& a, int o, int gw, int NGW, int lane) {
    asm volatile("" : "+v"(lane));
    unsigned char* ws = a.ws;
    const float* RAWM = (const float*)(ws + WO_RAWM); const bf16* QRAW = (const bf16*)(ws + WO_QRAW); const bf16* KVRAW = (const bf16*)(ws + WO_KVRAW);
    bf16 *QMC = (bf16*)(ws + WO_QMC), *QML = (bf16*)(ws + WO_QML), *KMC = (bf16*)(ws + WO_KMC), *KML = (bf16*)(ws + WO_KML), *VMC = (bf16*)(ws + WO_VMC), *VML = (bf16*)(ws + WO_VML);
    const float* ropeC = (const float*)(ws + WS_ROPE) + 96 * 32 * 2;
    const bool act = lane < 48, ropel = lane >= 32 && lane < 48;
    const int e0 = 4 * lane;
    f32x4 gq = {0.f, 0.f, 0.f, 0.f}, gk = gq;
    if (act) { gq = *(const f32x4*)(a.in[I_GQKM] + (size_t)(o * 2 + 0) * DQKC + e0); gk = *(const f32x4*)(a.in[I_GQKM] + (size_t)(o * 2 + 1) * DQKC + e0); }
    for (int row = gw; row < MKV; row += NGW) {
        const bool cache = row >= M, lat = !cache && row >= MC;
        int b, s; const float* kpe_src;
        if (cache) { b = (row - M) / PAST; s = LS + (row - M) % PAST; kpe_src = a.in[I_CKPE] + (((size_t)b * 2 + o) * PAST + (row - M) % PAST) * ROPEC; }
        else { b = lat ? (row - MC) / LS : row / CS; s = lat ? (row - MC) % LS : row % CS; kpe_src = RAWM + (size_t)row * NMLAP + QLORA + KVLORA; }
        const bool kv_lat = lat || cache;
        f32x4 cs4 = {1.f, 1.f, 1.f, 1.f}, sn4 = {0.f, 0.f, 0.f, 0.f};
        if (lat && ropel) { const int t0 = e0 - 128, part = t0 >> 5, p = part ? 32 + (s % GRIDW) : (s / GRIDW), i0 = t0 & 15; const bool firsth = (t0 & 16) == 0;
#pragma unroll
            for (int k = 0; k < 4; ++k) { const f32x2 t = *(const f32x2*)(ropeC + ((size_t)p * 16 + i0 + k) * 2); cs4[k] = t[0]; sn4[k] = firsth ? -t[1] : t[1]; } }
        f32x4 kpe = {0.f, 0.f, 0.f, 0.f};
        if (ropel) kpe = *(const f32x4*)(kpe_src + (e0 - 128));
#pragma unroll 2
        for (int h = 0; h < HC; ++h) {
            if (!cache) {
                f32x4 x = {0.f, 0.f, 0.f, 0.f};
                if (act) { const v2u w = *(const v2u*)(QRAW + (size_t)row * NUQ + h * DQKC + e0); x = (f32x4){bf_lo(w.x), bf_hi(w.x), bf_lo(w.y), bf_hi(w.y)}; }
                const float ss = wave_sum((x[0] * x[0] + x[1] * x[1]) + (x[2] * x[2] + x[3] * x[3]));
                x = x * (1.0f / sqrtf(ss * (1.0f / DQKC) + EPS)) * gq;
                f32x4 xp;
#pragma unroll
                for (int k = 0; k < 4; ++k) xp[k] = __shfl_xor(x[k], 4);
                x = x * cs4 + xp * sn4;
                if (act) { v2u w; w.x = pk2(x[0], x[1]); w.y = pk2(x[2], x[3]);
                    bf16* dst = lat ? QML + (((size_t)b * HC + h) * LS + s) * DQKC : QMC + (((size_t)b * HC + h) * CS + s) * DQKC;
                    *(v2u*)(dst + e0) = w; }
            }
            {
                f32x4 x = kpe;
                if (lane < 32) { const v2u w = *(const v2u*)(KVRAW + (size_t)row * NUKV + h * 256 + e0); x = (f32x4){bf_lo(w.x), bf_hi(w.x), bf_lo(w.y), bf_hi(w.y)}; }
                const float ss = wave_sum((x[0] * x[0] + x[1] * x[1]) + (x[2] * x[2] + x[3] * x[3]));
                x = x * (1.0f / sqrtf(ss * (1.0f / DQKC) + EPS)) * gk;
                f32x4 xp;
#pragma unroll
                for (int k = 0; k < 4; ++k) xp[k] = __shfl_xor(x[k], 4);
                x = x * cs4 + xp * sn4;
                if (act) { v2u w; w.x = pk2(x[0], x[1]); w.y = pk2(x[2], x[3]);
                    bf16* dst = kv_lat ? KML + (((size_t)b * HC + h) * LKV + s) * DQKC : KMC + (((size_t)b * HC + h) * CS + s) * DQKC;
                    *(v2u*)(dst + e0) = w; }
            }
            if (lane < 32) {
                const v2u w = *(const v2u*)(KVRAW + (size_t)row * NUKV + h * 256 + 128 + e0);
                bf16* dst = kv_lat ? VML + (((size_t)b * HC + h) * LKV + s) * DVC : VMC + (((size_t)b * HC + h) * CS + s) * DVC;
                *(v2u*)(dst + e0) = w; }
        }
    }
}
constexpr int ATT_LDS_E = 2 * att::SHM_V + 2 * 64 * 128 * 2 + 2048;
constexpr int ATT_LDS_O = 2 * att::SHM_V + 2 * 64 * 192 * 2 + 2048 + 32768;
static_assert(ATT_LDS_O <= RING_BYTES, "attention LDS");

__device__ __forceinline__ int diff_unit_of(int cu, int i, int G) {
    if (G == 256) { if (cu < 128) return i == 0 ? cu : (i == 1 ? 256 + cu : -1);
                    return i == 0 ? cu : (i <= 6 ? 384 + (cu - 128) * 6 + (i - 1) : -1); }
    const int u = cu + i * G; return u < 1152 ? u : -1;
}
__device__ __forceinline__ void diff_attn_phase(CArgs& a, int cu, int G, char* lds) {
    unsigned char* ws = a.ws; float* OATT = (float*)(ws + WE_OATT);
    for (int i = 0;; ++i) {
        const int u = diff_unit_of(cu, i, G); if (u < 0) break;
        const bf16 *Q, *K, *V; float* O; int seq;
        if (u < 384) { const int vh = u & 1, c = (u >> 1) & 1, qb = (u >> 2) & 7, bh = u >> 5;
            const int b = bh / HA, h = bh % HA;
            Q = (const bf16*)(ws + WE_QL) + (((size_t)bh * 2 + c) * LS + qb * 256) * 128;
            K = (const bf16*)(ws + WE_KL) + ((size_t)bh * 2 + c) * LKV * 128;
            V = (const bf16*)(ws + WE_VL) + ((size_t)bh * 2 + vh) * LKV * 128;
            O = OATT + (size_t)c * M * WA + (size_t)(MC + b * LS + qb * 256) * WA + h * 256 + vh * 128; seq = LKV;
        } else { const int v = u - 384; const int vh = v & 1, c = (v >> 1) & 1, bh = v >> 2; const int b = bh / HA, h = bh % HA;
            Q = (const bf16*)(ws + WE_QC) + ((size_t)bh * 2 + c) * CS * 128;
            K = (const bf16*)(ws + WE_KC) + ((size_t)bh * 2 + c) * CS * 128;
            V = (const bf16*)(ws + WE_VC) + ((size_t)bh * 2 + vh) * CS * 128;
            O = OATT + (size_t)c * M * WA + (size_t)(b * CS) * WA + h * 256 + vh * 128; seq = CS; }
        att::attn_dense_body<128, 128, false, float>(Q, K, V, O, WA, seq, lds);
    }
}
__device__ __forceinline__ int mla_unit_of(int cu, int i, int G) {
    if (G == 256) return i == 0 ? cu : (i <= 2 ? 256 + 2 * cu + (i - 1) : -1);
    const int u = cu + i * G; return u < 768 ? u : -1;
}
__device__ __forceinline__ void mla_attn_phase(CArgs& a, int cu, int G, char* lds) {
    unsigned char* ws = a.ws; bf16* AW = (bf16*)(ws + WS_AW);
    for (int i = 0;; ++i) {
        const int u = mla_unit_of(cu, i, G); if (u < 0) break;
        const bf16 *Q, *K, *V; bf16* O; int seq;
        if (u < 256) { const int qb = u & 7, bh = u >> 3; const int b = bh / HC, h = bh % HC;
            Q = (const bf16*)(ws + WO_QML) + ((size_t)bh * LS + qb * 256) * DQKC;
            K = (const bf16*)(ws + WO_KML) + (size_t)bh * LKV * DQKC;
            V = (const bf16*)(ws + WO_VML) + (size_t)bh * LKV * DVC;
            O = AW + (size_t)(MC + b * LS + qb * 256) * DM + h * 128; seq = LKV;
        } else { const int bh = u - 256; const int b = bh / HC, h = bh % HC;
            Q = (const bf16*)(ws + WO_QMC) + (size_t)bh * CS * DQKC;
            K = (const bf16*)(ws + WO_KMC) + (size_t)bh * CS * DQKC;
            V = (const bf16*)(ws + WO_VMC) + (size_t)bh * CS * DVC;
            O = AW + (size_t)(b * CS) * DM + h * 128; seq = CS; }
        att::attn_dense_body<192, 192, true, bf16>(Q, K, V, O, DM, seq, lds);
    }
}
struct DftOrder {
    const unsigned char* ws; int G, c, first_cu, mode;
    __device__ bool next(int i, pg8::Unit& u) const {
        if (c < first_cu) return false;
        const int id = i * (G - first_cu) + (c - first_cu);
        if (mode == 0) { if (id >= 64) return false; const int b = id >> 1, pnh = id & 1;
            u.pm = 0; u.pn = id; u.A = (const char*)(ws + WS_TABSC); u.B = (const char*)(ws + WE_YTC) + (size_t)(b * 512 + pnh * 256) * 512 * 2;
            u.z = (long)(b * CS) * 512 + pnh * 256;
        } else { if (id >= 256) return false; const int ks = id & 7, pnh = (id >> 3) & 1, b = (id >> 4) & 1, pm = id >> 5;
            u.pm = pm; u.pn = id; u.A = (const char*)(ws + WS_TABSL) + ((size_t)pm * 256 * 4096 + ks * 512) * 2;
            u.B = (const char*)(ws + WE_YTL) + ((size_t)(b * 512 + pnh * 256) * 4096 + ks * 512) * 2;
            u.z = (long)((WE_FOPL - WE_FOPC) / 4) + ((long)ks * ML + b * LS + pm * 256) * 512 + pnh * 256; }
        return true;
    }
};

__global__ void __launch_bounds__(NWAVES * 64, 2) fwd_kernel(Args args_by_value) {
    extern __shared__ __attribute__((aligned(16))) unsigned char lds_raw[];
    LAS unsigned char* lds = (LAS unsigned char*)lds_raw;
    volatile LAS unsigned* MISC = (volatile LAS unsigned*)(lds + MISC_OFF);
    const int tid = threadIdx.x, lane = tid & 63, wave = __builtin_amdgcn_readfirstlane(tid >> 6);
    const int G = gridDim.x, cu = blockIdx.x, gw = cu * NWAVES + wave, NGW = G * NWAVES;
    for (int u = tid; u < (LDS_BYTES - LDSCTL_OFF) / 4; u += NWAVES * 64) ((LAS unsigned*)(lds + LDSCTL_OFF))[u] = 0u;
    __syncthreads();
    XcdBarrier bar = xcd_barrier_post((unsigned*)(kargs()->ws + WS_CTL) + CW_BAR, MISC + 8);
    const int lo = kargs()->ph_lo, hi = kargs()->ph_hi;
    int ph = 0;
#ifndef SITE_MASK
#define SITE_MASK 0xFFFFFFFFull
#endif
#define SITE_ON(k) (((SITE_MASK) >> (k)) & 1ull)
#define PH_IN() (lo <= ph && ph < hi)
#define PH_END() do { if (lo <= ph && ph + 1 < hi) xcd_barrier(bar); ++ph; } while (0)

    if (SITE_ON(0) && PH_IN()) phase_prologue(*kargs(), lds, gw, NGW, wave, lane);
    PH_END();
    if (SITE_ON(1) && PH_IN()) phase_modreduce(*kargs(), gw, NGW, lane);
    PH_END();

#define WSL() CArgs& args = *kargs(); unsigned char* ws = args.ws; const float* MOD = (const float*)(ws + WS_MOD); bf16* H = (bf16*)(ws + WS_H); bf16* ACT = (bf16*)(ws + WS_ACT); bf16* AW = (bf16*)(ws + WS_AW); (void)MOD; (void)H; (void)ACT; (void)AW
    for (int f = 0; f < 2 * DEPTH; ++f) {
        const int l = f >> 1, j = f & 1;
        const bool first = (f == 0);
        if (SITE_ON(2) && PH_IN()) phase_norm(*kargs(), l, j ? 2 : 0, first, gw, NGW, lane);
        PH_END();
        if (SITE_ON(3) && PH_IN()) {
                    WSL();
            pg8::PlainOrder S; S.init(H, (const bf16*)(ws + WS_WGU) + (size_t)f * NGU * DM, M, NGU, DM, DM, G, cu);
            EpiSwiglu E{ACT};
            pg8::gemm_phase(lds + RING_OFF, pg8::Dims{DM, DM, DM / 64}, S, E);
        }
        PH_END();
        if (SITE_ON(4) && PH_IN()) {
                    WSL();
            pg8::PlainOrder S; S.init(ACT, (const bf16*)(ws + WS_WD) + (size_t)f * DM * DFF, M, DM, DFF, DFF, G, cu);
            EpiResid E{first ? args.in[I_XP] : args.out, first ? args.in[I_XS] : args.out + (size_t)MC * DM, args.out, MOD + (size_t)(l * 3) * MODW + (j ? 8 : 2) * DM, 0.5f};
            pg8::gemm_phase(lds + RING_OFF, pg8::Dims{DFF, DFF, DFF / 64}, S, E);
        }
        PH_END();
        if (j == 0) {
            if (SITE_ON(5) && PH_IN()) phase_norm(*kargs(), l, 1, false, gw, NGW, lane);
            PH_END();
            const int e = l >> 1;
            if ((l & 1) == 0) {
                if (SITE_ON(6) && PH_IN()) {
                    WSL();
                    pg8::PlainOrder S; S.init(H, (const bf16*)(ws + WS_WINAB) + (size_t)e * NAB * DM, M, NAB, DM, DM, G, cu);
                    EpiBf16 E{(bf16*)(ws + WE_RAW), 3 * WA, 3 * WA, (bf16*)(ws + WE_F), WB};
                    pg8::gemm_phase(lds + RING_OFF, pg8::Dims{DM, DM, DM / 64}, S, E);
                }
                PH_END();
                if (SITE_ON(7) && PH_IN()) {
                    WSL();
                    phase_even_post(args, e, gw, NGW, lane);
                    pg8::PlainOrder S; S.init(ws + WS_TABD, ws + WE_F, 1024, M, WB, WB, G, cu);
                    EpiYt E{(bf16*)(ws + WE_YTC), (bf16*)(ws + WE_YTL)};
                    pg8::gemm_phase(lds + RING_OFF, pg8::Dims{WB, WB, WB / 64}, S, E);
                }
                PH_END();
                if (SITE_ON(8) && PH_IN()) {
                    WSL();
                    diff_attn_phase(args, cu, G, (char*)lds_raw);
                    EpiF32 E{(float*)(ws + WE_FOPC), 512, 1};
                    { DftOrder S{ws, G, cu, G == 256 ? 128 : 0, 1}; pg8::gemm_phase(lds + RING_OFF, pg8::Dims{4096, 4096, 8}, S, E); }
                    { DftOrder S{ws, G, cu, G == 256 ? 128 : 0, 0}; pg8::gemm_phase(lds + RING_OFF, pg8::Dims{512, 512, 8}, S, E); }
                }
                PH_END();
                if (SITE_ON(9) && PH_IN()) phase_even_combine(*kargs(), e, gw, NGW, lane);
                PH_END();
                if (SITE_ON(10) && PH_IN()) {
                    WSL();
                    pg8::PlainOrder S; S.init(AW, (const bf16*)(ws + WS_WOUTAB) + (size_t)e * DM * DM, M, DM, DM, DM, G, cu);
                    EpiResid E{args.out, args.out + (size_t)MC * DM, args.out, MOD + (size_t)(l * 3) * MODW + 5 * DM, 1.0f};
                    pg8::gemm_phase(lds + RING_OFF, pg8::Dims{DM, DM, DM / 64}, S, E);
                }
                PH_END();
            } else {
                if (SITE_ON(11) && PH_IN()) {
                    WSL();
                    pg8::PlainOrder S; S.init(H, (const bf16*)(ws + WS_WINMLA) + (size_t)e * NMLAP * DM, M, NMLAP, DM, DM, G, cu);
                    EpiF32 E{(float*)(ws + WO_RAWM), NMLAP, 0};
                    pg8::gemm_phase(lds + RING_OFF, pg8::Dims{DM, DM, DM / 64}, S, E);
                }
                PH_END();
                if (SITE_ON(12) && PH_IN()) phase_odd_post1(*kargs(), e, gw, NGW, lane);
                PH_END();
                if (SITE_ON(13) && PH_IN()) {
                    WSL();
                    { pg8::PlainOrder S; S.init(ws + WO_CQN, (const bf16*)(ws + WS_WUQ) + (size_t)e * NUQ * QLORA, M, NUQ, QLORA, QLORA, G, cu);
                      EpiBf16 E{(bf16*)(ws + WO_QRAW), NUQ, 1 << 30, nullptr, 0};
                      pg8::gemm_phase(lds + RING_OFF, pg8::Dims{QLORA, QLORA, QLORA / 64}, S, E); }
                    { pg8::PlainOrder S; S.init(ws + WO_CKVN, (const bf16*)(ws + WS_WUKV) + (size_t)e * NUKV * KVLORA, MKV, NUKV, KVLORA, KVLORA, G, (cu + 128) % G);
                      EpiBf16 E{(bf16*)(ws + WO_KVRAW), NUKV, 1 << 30, nullptr, 0};
                      pg8::gemm_phase(lds + RING_OFF, pg8::Dims{KVLORA, KVLORA, KVLORA / 64}, S, E); }
                }
                PH_END();
                if (SITE_ON(14) && PH_IN()) phase_odd_post2(*kargs(), e, gw, NGW, lane);
                PH_END();
                if (SITE_ON(15) && PH_IN()) {
                    WSL();
                    mla_attn_phase(args, cu, G, (char*)lds_raw);
                }
                PH_END();
                if (SITE_ON(16) && PH_IN()) {
                    WSL();
                    pg8::PlainOrder S; S.init(AW, (const bf16*)(ws + WS_WO) + (size_t)e * DM * DM, M, DM, DM, DM, G, cu);
                    EpiResid E{args.out, args.out + (size_t)MC * DM, args.out, MOD + (size_t)(l * 3) * MODW + 5 * DM, 1.0f};
                    pg8::gemm_phase(lds + RING_OFF, pg8::Dims{DM, DM, DM / 64}, S, E);
                }
                PH_END();
            }
        }
    }
#undef PH_IN
#undef PH_END
}
constexpr int N_PHASES = 2 + 8 * 3 + 4 + 2 * 5 + 2 * 6;

#ifndef MK_N_LAUNCHES
#define MK_N_LAUNCHES 1
#endif
extern "C" void kernel_launch(void* const* d_in, const int* in_sizes, int n_in, void* d_out, int out_size, void* d_ws, size_t ws_size, hipStream_t stream) {
    static int grid = 0;
    if (grid == 0) {
        if (n_in != 26 || (size_t)out_size != OUT_END || ws_size < WS_END) { fprintf(stderr, "kernel_launch: shape mismatch: n_in %d out %d ws %zu (need %zu)\n", n_in, out_size, ws_size, (size_t)WS_END); grid = -1; return; }
        int dev = 0, cus = 0, per_cu = 0;
        if (hipGetDevice(&dev) != hipSuccess || hipDeviceGetAttribute(&cus, hipDeviceAttributeMultiprocessorCount, dev) != hipSuccess) { grid = -1; return; }
        if (hipFuncSetAttribute((const void*)fwd_kernel, hipFuncAttributeMaxDynamicSharedMemorySize, LDS_BYTES) != hipSuccess) { fprintf(stderr, "kernel_launch: hipFuncSetAttribute failed\n"); grid = -1; return; }
        if (hipOccupancyMaxActiveBlocksPerMultiprocessor(&per_cu, (const void*)fwd_kernel, NWAVES * 64, LDS_BYTES) != hipSuccess || per_cu < 1)
            fprintf(stderr, "kernel_launch: occupancy query reports %d workgroups per CU\n", per_cu);
        (void)hipGetLastError();
        grid = cus;
    }
    if (grid < 0) return;
    if (hipMemsetAsync((char*)d_ws + WS_CTL, 0, CTL_ZERO_BYTES, stream) != hipSuccess) { fprintf(stderr, "kernel_launch: memset failed\n"); return; }
    Args a{};
    for (int i = 0; i < 26; ++i) a.in[i] = (const float*)d_in[i];
    a.out = (float*)d_out; a.ws = (unsigned char*)d_ws;
    if (MK_N_LAUNCHES == 1) {
        a.ph_lo = 0; a.ph_hi = N_PHASES;
        hipLaunchKernelGGL(fwd_kernel, dim3(grid), dim3(NWAVES * 64), LDS_BYTES, stream, a);
    } else {
        for (int p = 0; p < N_PHASES; ++p) { a.ph_lo = p; a.ph_hi = p + 1; hipLaunchKernelGGL(fwd_kernel, dim3(grid), dim3(NWAVES * 64), LDS_BYTES, stream, a); }
    }
    const hipError_t le = hipPeekAtLastError();
    if (le != hipSuccess) fprintf(stderr, "kernel_launch: launch failed: %s\n", hipGetErrorName(le));
}
```
